# Optimizing an MI355X kernel written in HIP

```python
import math
import jax, jax.numpy as jnp
from jax import lax
import numpy as np

D_MODEL = 1024
BATCH = 32
SEQ = 2048
DEPTH = 1
DEC_BATCH = 8
DEC_SEQ = 2048
PAST_LEN = 128

HEAD_DIM = 64
N_HEADS_A = 8
N_KV_A = 2
WIN_A = 128
DILATED_GROUPS = ((128, 1), (512, 4), (2048, 16))
HB_PER_GROUP = 4
N_HEADS_B = HB_PER_GROUP * len(DILATED_GROUPS)
N_HEADS_M = 4
HEAD_DIM_M = 128
N_MEM = 256
D_FF = 4 * D_MODEL
NUM_BUCKETS = 32
MAX_DIST = 1024
N_BIAS_HEADS = N_HEADS_A + N_HEADS_B
EPS = 1e-6
NEG = -1e30

W_A = N_HEADS_A * HEAD_DIM
W_KV_A = N_KV_A * HEAD_DIM
W_B = N_HEADS_B * HEAD_DIM
W_B_OUT = HB_PER_GROUP * HEAD_DIM
W_M = N_HEADS_M * HEAD_DIM_M
IN_SPLITS = (W_A, W_KV_A, W_KV_A, W_B, W_B, W_B, W_M, D_MODEL, D_MODEL, D_MODEL)
N_IN = sum(IN_SPLITS)

kernel_name = "hybrid_gated_local_dilated_memory_encoder"


def t5_bucket(rel):
    half = NUM_BUCKETS // 2
    ret = (rel > 0).astype(np.int32) * half
    n = np.abs(rel)
    max_exact = half // 2
    large = max_exact + (np.log(np.maximum(n, 1) / max_exact) / np.log(MAX_DIST / max_exact)
                         * (half - max_exact)).astype(np.int32)
    large = np.minimum(large, half - 1)
    return (ret + np.where(n < max_exact, n, large)).astype(np.int32)


def rms_norm(x, g):
    xf = x.astype(jnp.float32)
    y = xf * lax.rsqrt(jnp.mean(xf * xf, axis=-1, keepdims=True) + EPS)
    return (y * g.astype(jnp.float32)).astype(x.dtype)


def banded_attention(q, k, v, bias_off, half, sink):
    B_, L, H, Dh = q.shape
    G = k.shape[2]
    R = H // G
    W = half
    nb = -(-L // W)
    Lp = nb * W
    pad = Lp - L
    qb = jnp.pad(q, ((0, 0), (0, pad), (0, 0), (0, 0))).reshape(B_, nb, W, G, R, Dh)

    def key_blocks(t):
        tp = jnp.pad(t, ((0, 0), (W, pad + W), (0, 0), (0, 0))).reshape(B_, nb + 2, W, G, Dh)
        return jnp.concatenate([tp[:, :-2], tp[:, 1:-1], tp[:, 2:]], axis=2)

    kb = key_blocks(k)
    vb = key_blocks(v)
    valid = np.pad(np.ones(L, bool), (W, pad + W)).reshape(nb + 2, W)
    valid = np.concatenate([valid[:-2], valid[1:-1], valid[2:]], axis=1)
    off = np.arange(3 * W)[None, :] - W - np.arange(W)[:, None]
    mask = (np.abs(off) <= W)[None] & valid[:, None, :]
    bias = bias_off[:, np.clip(off + W, 0, 2 * W)].astype(jnp.float32).reshape(G, R, W, 3 * W)
    s = jnp.einsum('bnqgrd,bnkgd->bngrqk', qb, kb,
                   preferred_element_type=jnp.float32) * (Dh ** -0.5) + bias
    s = jnp.where(mask[None, :, None, None], s, NEG)
    m = jnp.max(s, axis=-1)
    if sink is not None:
        sk = sink.astype(jnp.float32).reshape(G, R)[None, None, :, :, None]
        m = jnp.maximum(m, sk)
    p = jnp.exp(s - m[..., None])
    den = jnp.sum(p, axis=-1)
    if sink is not None:
        den = den + jnp.exp(sk - m)
    out = jnp.einsum('bngrqk,bnkgd->bnqgrd', p, vb.astype(jnp.float32))
    out = out / jnp.moveaxis(den, -1, 2)[..., None]
    out = out.reshape(B_, Lp, H, Dh)[:, :L].astype(q.dtype)
    lse = jnp.moveaxis(m + jnp.log(den), -1, 2).reshape(B_, Lp, H)[:, :L]
    return out, lse


def dilated_attention(q, k, v, rel_bias):
    B_, S, _, Dh = q.shape
    outs, lses = [], []
    for g, (win, dil) in enumerate(DILATED_GROUPS):
        hs = slice(g * HB_PER_GROUP, (g + 1) * HB_PER_GROUP)
        half = win // (2 * dil)
        Ld = S // dil

        def strided(t):
            return (t[:, :, hs].reshape(B_, Ld, dil, HB_PER_GROUP, Dh)
                    .transpose(0, 2, 1, 3, 4).reshape(B_ * dil, Ld, HB_PER_GROUP, Dh))

        cols = N_HEADS_A + g * HB_PER_GROUP
        rel = dil * np.arange(-half, half + 1)
        bias_off = rel_bias[t5_bucket(rel)][:, cols:cols + HB_PER_GROUP].T
        o, l = banded_attention(strided(q), strided(k), strided(v), bias_off, half, None)
        o = o.reshape(B_, dil, Ld, HB_PER_GROUP, Dh).transpose(0, 2, 1, 3, 4).reshape(B_, S, HB_PER_GROUP, Dh)
        l = l.reshape(B_, dil, Ld, HB_PER_GROUP).transpose(0, 2, 1, 3).reshape(B_, S, HB_PER_GROUP)
        outs.append(o)
        lses.append(l)
    w = jax.nn.softmax(jnp.stack(lses), axis=0)
    out = jnp.sum(w[..., None] * jnp.stack(outs).astype(jnp.float32), axis=0)
    return out.astype(q.dtype)


def memory_attention(q, mk, mv):
    s = jnp.einsum('bshd,bmhd->bhsm', q, mk, preferred_element_type=jnp.float32) * (q.shape[-1] ** -0.5)
    p = jax.nn.softmax(s, axis=-1)
    return jnp.einsum('bhsm,bmhd->bshd', p, mv.astype(jnp.float32)).astype(q.dtype)


def encoder_layer(x, mem, rel_bias, norm1_g, w_in, mem_norm_g, w_mem_kv, sink_logit,
                  w_branch_a, w_branch_b, w_branch_m, w_out, norm2_g, w_up, w_down):
    B_, S, _ = x.shape
    h = rms_norm(x, norm1_g)
    proj = h @ w_in
    qa, ka, va, qb, kb, vb, qm, ga, gb, gm = jnp.split(
        proj, [int(c) for c in np.cumsum(IN_SPLITS)[:-1]], axis=-1)
    bias_a = rel_bias[t5_bucket(np.arange(-WIN_A, WIN_A + 1))][:, :N_HEADS_A].T
    oa, _ = banded_attention(qa.reshape(B_, S, N_HEADS_A, HEAD_DIM),
                             ka.reshape(B_, S, N_KV_A, HEAD_DIM),
                             va.reshape(B_, S, N_KV_A, HEAD_DIM), bias_a, WIN_A, sink_logit)
    ob = dilated_attention(qb.reshape(B_, S, N_HEADS_B, HEAD_DIM),
                           kb.reshape(B_, S, N_HEADS_B, HEAD_DIM),
                           vb.reshape(B_, S, N_HEADS_B, HEAD_DIM), rel_bias)
    mkv = rms_norm(mem, mem_norm_g) @ w_mem_kv
    mk, mv = jnp.split(mkv, 2, axis=-1)
    Mn = mem.shape[1]
    om = memory_attention(qm.reshape(B_, S, N_HEADS_M, HEAD_DIM_M),
                          mk.reshape(B_, Mn, N_HEADS_M, HEAD_DIM_M),
                          mv.reshape(B_, Mn, N_HEADS_M, HEAD_DIM_M))
    merged = (jax.nn.sigmoid(ga) * (oa.reshape(B_, S, W_A) @ w_branch_a)
              + jax.nn.sigmoid(gb) * (ob.reshape(B_, S, W_B_OUT) @ w_branch_b)
              + jax.nn.sigmoid(gm) * (om.reshape(B_, S, W_M) @ w_branch_m))
    x = x + merged @ w_out
    h2 = rms_norm(x, norm2_g)
    x = x + jnp.square(jax.nn.relu(h2 @ w_up)) @ w_down
    return x


def trunk(x, mem, rel_bias, norm1_g, w_in, mem_norm_g, w_mem_kv, sink_logit,
          w_branch_a, w_branch_b, w_branch_m, w_out, norm2_g, w_up, w_down, final_norm_g):
    for layer in range(DEPTH):
        x = encoder_layer(x, mem, rel_bias, norm1_g[layer], w_in[layer], mem_norm_g[layer],
                          w_mem_kv[layer], sink_logit[layer], w_branch_a[layer], w_branch_b[layer],
                          w_branch_m[layer], w_out[layer], norm2_g[layer], w_up[layer], w_down[layer])
    return rms_norm(x, final_norm_g)


def setup_inputs(seed: int = 0) -> dict:
    key = jax.random.key(seed)
    ks = jax.random.split(key, 20)
    f32 = jnp.float32

    def dense(k, shape):
        return jax.random.normal(k, shape, f32) * (shape[-2] ** -0.5)

    def gain(k, shape):
        return 1.0 + 0.1 * jax.random.normal(k, shape, f32)

    return {
        "x_prompt": jax.random.normal(ks[0], (BATCH, SEQ, D_MODEL), f32),
        "x_sample": jax.random.normal(ks[1], (DEC_BATCH, DEC_SEQ, D_MODEL), f32),
        "mem_prompt": jax.random.normal(ks[2], (BATCH, N_MEM, D_MODEL), f32),
        "mem_sample": jax.random.normal(ks[3], (DEC_BATCH, N_MEM, D_MODEL), f32),
        "rel_bias": 0.5 * jax.random.normal(ks[4], (NUM_BUCKETS, N_BIAS_HEADS), f32),
        "norm1_g": gain(ks[5], (DEPTH, D_MODEL)),
        "w_in": dense(ks[6], (DEPTH, D_MODEL, N_IN)),
        "mem_norm_g": gain(ks[7], (DEPTH, D_MODEL)),
        "w_mem_kv": dense(ks[8], (DEPTH, D_MODEL, 2 * W_M)),
        "sink_logit": 0.5 * jax.random.normal(ks[9], (DEPTH, N_HEADS_A), f32),
        "w_branch_a": dense(ks[10], (DEPTH, W_A, D_MODEL)),
        "w_branch_b": dense(ks[11], (DEPTH, W_B_OUT, D_MODEL)),
        "w_branch_m": dense(ks[12], (DEPTH, W_M, D_MODEL)),
        "w_out": dense(ks[13], (DEPTH, D_MODEL, D_MODEL)),
        "norm2_g": gain(ks[14], (DEPTH, D_MODEL)),
        "w_up": dense(ks[15], (DEPTH, D_MODEL, D_FF)),
        "w_down": dense(ks[16], (DEPTH, D_FF, D_MODEL)),
        "final_norm_g": gain(ks[17], (D_MODEL,)),
    }


def reference(x_prompt, x_sample, mem_prompt, mem_sample, rel_bias, norm1_g, w_in, mem_norm_g,
              w_mem_kv, sink_logit, w_branch_a, w_branch_b, w_branch_m, w_out, norm2_g, w_up,
              w_down, final_norm_g):
    y_prompt = trunk(x_prompt, mem_prompt, rel_bias, norm1_g, w_in, mem_norm_g, w_mem_kv, sink_logit,
                     w_branch_a, w_branch_b, w_branch_m, w_out, norm2_g, w_up, w_down, final_norm_g)
    y_sample = trunk(x_sample, mem_sample, rel_bias, norm1_g, w_in, mem_norm_g, w_mem_kv, sink_logit,
                     w_branch_a, w_branch_b, w_branch_m, w_out, norm2_g, w_up, w_down, final_norm_g)
    return (y_prompt, y_sample)
```

```cpp
#include <hip/hip_runtime.h>
#include <hip/hip_cooperative_groups.h>
#include <cstdio>
#include <cstdint>
namespace cg = cooperative_groups;

#define LAS __attribute__((address_space(3)))
typedef unsigned short bf16_t;
typedef short bf16x8 __attribute__((ext_vector_type(8)));
typedef short s16x4 __attribute__((ext_vector_type(4)));
typedef short v4i16_t __attribute__((ext_vector_type(4)));
typedef float f32x4 __attribute__((ext_vector_type(4)));
typedef float f32x16 __attribute__((ext_vector_type(16)));
typedef unsigned u32x4 __attribute__((ext_vector_type(4)));
typedef unsigned u32x2 __attribute__((ext_vector_type(2)));
typedef int v8i_t __attribute__((ext_vector_type(8)));

constexpr int DM = 1024, TP = 32 * 2048, TS = 8 * 2048, TT = TP + TS;
constexpr int NB = 40, SEQ = 2048, NMEM = 256, TMEM = NB * NMEM;
constexpr int NQKV = 3584, NIN = 6656, LDH = 2304, LDW3 = 4352, DFF = 4096;
constexpr int HC_OA = 1024, HC_OB = 1536, HC_OM = 1792;
constexpr float EPS = 1e-6f;
constexpr size_t MiB = 1u << 20;
constexpr int NBA = 320, NBB = 192;
constexpr size_t WS_BIASA = 1 * MiB, WS_BIASB = WS_BIASA + 8 * NBA * 4;
constexpr size_t WS_WQKV = 2 * MiB, WS_W3 = 9 * MiB, WS_WMEM = 18 * MiB, WS_WOUT = 20 * MiB, WS_WUP = 22 * MiB, WS_WDN = 30 * MiB;
constexpr size_t WS_MEMN = 38 * MiB, WS_MKV = 58 * MiB, WS_SSQ = 78 * MiB, WS_LSE = 83 * MiB;
constexpr size_t WS_QKV = 88 * MiB, WS_HCAT = 648 * MiB, WS_END = 1008 * MiB;
constexpr size_t WS_X1B = 88 * MiB, WS_MERGED = 248 * MiB, WS_HID = 248 * MiB;
constexpr size_t DO_OG = 0;
constexpr int LDS_BYTES = 163840;

__device__ __forceinline__ int lane_id() { int l; asm volatile("v_mbcnt_lo_u32_b32 %0, -1, 0\n\tv_mbcnt_hi_u32_b32 %0, -1, %0" : "=v"(l)); return l; }
__device__ __forceinline__ unsigned f2bf(float f) { unsigned u = __builtin_bit_cast(unsigned, f); return (u + 0x7fffu + ((u >> 16) & 1u)) >> 16; }
typedef float f32x2_t __attribute__((ext_vector_type(2))); typedef __bf16 bf16x2_t __attribute__((ext_vector_type(2)));
__device__ __forceinline__ unsigned pk2(float lo, float hi) { f32x2_t v = {lo, hi}; bf16x2_t b = __builtin_convertvector(v, bf16x2_t); return __builtin_bit_cast(unsigned, b); }
__device__ __forceinline__ unsigned pk_fp8x4(float a, float b, float c, float d) { int w = 0; w = __builtin_amdgcn_cvt_pk_fp8_f32(a, b, w, false); w = __builtin_amdgcn_cvt_pk_fp8_f32(c, d, w, true); return (unsigned)w; }
__device__ __forceinline__ float bf2f(unsigned short b) { return __builtin_bit_cast(float, (unsigned)b << 16); }
__device__ __forceinline__ float wave_sum(float v) {
#pragma unroll
    for (int o = 1; o < 64; o <<= 1) v += __shfl_xor(v, o);
    return v;
}
__device__ __forceinline__ int t5_bucket(int rel) {
    int n = rel < 0 ? -rel : rel;
    int b = n < 8 ? n : 8 + (n >= 15) + (n >= 27) + (n >= 50) + (n >= 91) + (n >= 166) + (n >= 305) + (n >= 559);
    return b + (rel > 0 ? 16 : 0);
}

namespace pg8 {
constexpr int BM = 256, BK = 64, HALF = 128, HTB = HALF * BK * 2, STAGE_BYTES = 8 * HTB, NXCD = 8, WGM = 8;
__device__ __forceinline__ int lds_byte(int r, int c) { const int st = (r >> 4) * 2 + (c >> 5), rr = r & 15, cc = c & 31, ob = rr * 64 + cc * 2; return st * 1024 + (ob ^ (((ob >> 9) & 1) << 5)); }
__device__ __forceinline__ void stage_rc(int b, int& R, int& C) { const int st = b / 1024, sb = b % 1024, swz = sb ^ (((sb >> 9) & 1) << 5); R = (st >> 1) * 16 + swz / 64; C = (st & 1) * 32 + (swz % 64) / 2; }
__device__ __forceinline__ int perm32(int rho) { const int n = rho >> 4, i = rho & 15; return 8 * (i >> 2) + 4 * n + (i & 3); }

struct Unit { int pm, pn, aoff, boff, nt, mode; };
struct Gemm { const bf16_t* A; const bf16_t* Bt; int lda, ldb; };

__device__ __forceinline__ void tile_of(int L, int nM, int nN, int& pm, int& pn) {
    const int nwg = nM * nN; int wgid = L;
    { const int q = nwg / NXCD, r = nwg % NXCD, xcd = wgid % NXCD, off = wgid / NXCD; wgid = (xcd < r ? xcd * (q + 1) : r * (q + 1) + (xcd - r) * q) + off; }
    const int nig = WGM * nN, gid = wgid / nig, fm = gid * WGM, gsz = (nM - fm) < WGM ? (nM - fm) : WGM;
    pm = fm + ((wgid % nig) % gsz); pn = (wgid % nig) / gsz;
}
template <int NSUB> struct Sched {
    int nM, nN, G, c, nt0;
    __device__ __forceinline__ bool next(int i, Unit& u) const {
        const int ti = (NSUB == 1) ? i : i / NSUB, sub = (NSUB == 1) ? 0 : i - ti * NSUB;
        const long L = (long)ti * G + c; if (L >= (long)nM * nN) return false;
        tile_of((int)L, nM, nN, u.pm, u.pn);
        if (NSUB == 1) { u.aoff = 0; u.boff = 0; u.nt = nt0; u.mode = 0; }
        else {
            const int br = sub >> 1;
            if ((sub & 1) == 0) { u.aoff = 0; u.boff = 512 * br; u.nt = 8; u.mode = 0; }
            else { u.aoff = br == 0 ? 1024 : (br == 1 ? 1280 : 1408); u.boff = 1536 + (br == 0 ? 0 : (br == 1 ? 256 : 384)); u.nt = br == 1 ? 2 : 4; u.mode = br + 1; }
        }
        asm volatile("" : "+s"(u.nt));
        return true;
    }
};

struct SchedQkv {
    int c, nt0;
    __device__ __forceinline__ bool next(int i, Unit& u) const {
        int L;
        if (i < 17) L = i * 256 + c;
        else if (c < 96 && i == 17) L = 17 * 256 + c;
        else if (c < 32 && i == 18) L = 17 * 256 + 96 + c;
        else return false;
        tile_of(L, TT / 256, NQKV / 256, u.pm, u.pn);
        u.aoff = 0; u.boff = 0; u.nt = nt0; u.mode = 0;
        return true;
    }
};

struct EpiStoreBf16 {
    static constexpr bool PERM = true;
    bf16_t* O; int ldc; float sc;
    __device__ __forceinline__ void operator()(const f32x4 (&acc)[2][2][4][2], const Unit& u, int wr, int wc, int fr, int fq) const {
        asm volatile("" : "+v"(fr), "+v"(fq));
        const int row0 = u.pm * BM + wr * 64 + fr, col0 = u.pn * BM + wc * 32 + 8 * fq;
#pragma unroll
        for (int ai = 0; ai < 2; ++ai)
#pragma unroll
            for (int m = 0; m < 4; ++m) { bf16_t* rowp = O + (size_t)(row0 + ai * HALF + m * 16) * ldc + col0;
#pragma unroll
                for (int bj = 0; bj < 2; ++bj) { const f32x4 v0 = acc[ai][bj][m][0] * sc, v1 = acc[ai][bj][m][1] * sc;
                    u32x4 w; w.x = pk2(v0[0], v0[1]); w.y = pk2(v0[2], v0[3]); w.z = pk2(v1[0], v1[1]); w.w = pk2(v1[2], v1[3]);
                    *(u32x4*)(rowp + bj * HALF) = w; } }
    }
};
struct EpiUp {
    static constexpr bool PERM = true;
    bf16_t* O; const float* ssq;
    __device__ __forceinline__ void operator()(const f32x4 (&acc)[2][2][4][2], const Unit& u, int wr, int wc, int fr, int fq) const {
        const int row0 = u.pm * BM + wr * 64 + fr, col0 = u.pn * BM + wc * 32 + 8 * fq;
        f32x4 sp[2][4];
#pragma unroll
        for (int ai = 0; ai < 2; ++ai)
#pragma unroll
            for (int m = 0; m < 4; ++m) sp[ai][m] = *(const f32x4*)(ssq + (size_t)(row0 + ai * HALF + m * 16) * 16 + 4 * fq);
#pragma unroll
        for (int ai = 0; ai < 2; ++ai)
#pragma unroll
            for (int m = 0; m < 4; ++m) { const int row = row0 + ai * HALF + m * 16;
                float t = (sp[ai][m][0] + sp[ai][m][1]) + (sp[ai][m][2] + sp[ai][m][3]); t += __shfl_xor(t, 16); t += __shfl_xor(t, 32);
                const float rs = rsqrtf(t * (1.0f / DM) + EPS);
                bf16_t* rowp = O + (size_t)row * DFF + col0;
#pragma unroll
                for (int bj = 0; bj < 2; ++bj) { f32x4 v0 = acc[ai][bj][m][0] * rs, v1 = acc[ai][bj][m][1] * rs;
#pragma unroll
                    for (int e = 0; e < 4; ++e) { v0[e] = fmaxf(v0[e], 0.f); v0[e] *= v0[e]; v1[e] = fmaxf(v1[e], 0.f); v1[e] *= v1[e]; }
                    u32x4 w; w.x = pk2(v0[0], v0[1]); w.y = pk2(v0[2], v0[3]); w.z = pk2(v1[0], v1[1]); w.w = pk2(v1[2], v1[3]);
                    *(u32x4*)(rowp + bj * HALF) = w; } }
    }
};
__device__ __forceinline__ f32x4 unpk4(u32x2 w) { f32x4 r; r[0] = __builtin_bit_cast(float, w.x << 16); r[1] = __builtin_bit_cast(float, w.x & 0xffff0000u); r[2] = __builtin_bit_cast(float, w.y << 16); r[3] = __builtin_bit_cast(float, w.y & 0xffff0000u); return r; }
__device__ __forceinline__ u32x2 pk4(f32x4 v) { u32x2 w; w.x = pk2(v[0], v[1]); w.y = pk2(v[2], v[3]); return w; }
struct EpiGate {
    static constexpr bool PERM = true;
    u32x2* tg_; u32x2* tm_; bf16_t* O;
    __device__ __forceinline__ void operator()(const f32x4 (&acc)[2][2][4][2], const Unit& u, int wr, int wc, int fr, int fq) const {
        const int mode = u.mode;
        u32x2* tg = tg_; u32x2* tm = tm_;
        asm volatile("" : "+v"(tg), "+v"(tm));
        if (mode == 0) {
#pragma unroll
            for (int ai = 0; ai < 2; ++ai)
#pragma unroll
                for (int bj = 0; bj < 2; ++bj)
#pragma unroll
                    for (int m = 0; m < 4; ++m)
#pragma unroll
                        for (int n = 0; n < 2; ++n) { const int idx = ((ai * 2 + bj) * 4 + m) * 2 + n; f32x4 a = acc[ai][bj][m][n], s;
#pragma unroll
                            for (int e = 0; e < 4; ++e) s[e] = __builtin_amdgcn_rcpf(1.0f + __builtin_amdgcn_exp2f(-1.4426950408889634f * a[e]));
                            tg[idx * 64] = pk4(s); if (n) asm volatile("" ::: "memory"); }
        } else {
            const int row0 = u.pm * BM + wr * 64 + fr, col0 = u.pn * BM + wc * 32 + 8 * fq;
#pragma unroll
            for (int ai = 0; ai < 2; ++ai) {
                u32x2 g[16], t[16];
#pragma unroll
                for (int k = 0; k < 16; ++k) { g[k] = tg[(ai * 16 + k) * 64]; if (mode != 1) t[k] = tm[(ai * 16 + k) * 64]; }
#pragma unroll
                for (int bj = 0; bj < 2; ++bj)
#pragma unroll
                    for (int m = 0; m < 4; ++m) { const int k = (bj * 4 + m) * 2;
                        f32x4 v0 = unpk4(g[k]) * acc[ai][bj][m][0], v1 = unpk4(g[k + 1]) * acc[ai][bj][m][1];
                        if (mode != 1) { v0 += unpk4(t[k]); v1 += unpk4(t[k + 1]); }
                        if (mode != 3) { tm[(ai * 16 + k) * 64] = pk4(v0); tm[(ai * 16 + k + 1) * 64] = pk4(v1); }
                        else { u32x4 w; w.x = pk2(v0[0], v0[1]); w.y = pk2(v0[2], v0[3]); w.z = pk2(v1[0], v1[1]); w.w = pk2(v1[2], v1[3]);
                               *(u32x4*)(O + (size_t)(row0 + ai * HALF + m * 16) * DM + col0 + bj * HALF) = w; } }
                asm volatile("" ::: "memory");
            }
        }
    }
};
template <bool GATE> struct SchedFix {
    int pm, pn;
    __device__ __forceinline__ bool next(int i, Unit& u) const {
        int lim = 3; asm volatile("" : "+s"(lim));
        asm volatile("" : "+s"(i));
        if (i >= lim) return false;
        u.pm = pm; u.pn = pn; u.mode = i;
        if (GATE) { u.aoff = 0; u.boff = i * 524288; u.nt = 8; }
        else { u.aoff = i == 0 ? 1024 : (i == 1 ? 1280 : 1408); u.boff = i == 0 ? 0 : (i == 1 ? 256 : 384); u.nt = i == 1 ? 2 : 4; }
        asm volatile("" : "+s"(u.nt));
        return true;
    }
};
struct EpiGate6 {
    static constexpr bool PERM = true;
    u32x2* tb_; bf16_t* O;
    __device__ __forceinline__ void operator()(const f32x4 (&acc)[2][2][4][2], const Unit& u, int wr, int wc, int fr, int fq) const {
        const int mode = u.mode;
        const int loff = (wr * 4 + wc) * (32 * 64) + fq * 16 + fr;
        u32x2* tg = tb_ + loff; u32x2* tm = tb_ + 32 * 512 + loff;
        asm volatile("" : "+v"(tg), "+v"(tm));
        if (mode == 0) {
#pragma unroll
            for (int ai = 0; ai < 2; ++ai)
#pragma unroll
                for (int bj = 0; bj < 2; ++bj)
#pragma unroll
                    for (int m = 0; m < 4; ++m)
#pragma unroll
                        for (int n = 0; n < 2; ++n) { const int idx = ((ai * 2 + bj) * 4 + m) * 2 + n; f32x4 a = acc[ai][bj][m][n], sg;
#pragma unroll
                            for (int e = 0; e < 4; ++e) sg[e] = __builtin_amdgcn_rcpf(1.0f + __builtin_amdgcn_exp2f((-1.4426950408889634f / 32.0f) * a[e]));
                            tg[idx * 64] = pk4(sg); if (n) asm volatile("" ::: "memory"); }
        } else {
            const int row0 = u.pm * BM + wr * 64 + fr, col0 = u.pn * BM + wc * 32 + 8 * fq;
#pragma unroll
            for (int ai = 0; ai < 2; ++ai) {
                u32x2 g[16], t[16];
#pragma unroll
                for (int k = 0; k < 16; ++k) { g[k] = tg[(ai * 16 + k) * 64]; if (mode != 1) t[k] = tm[(ai * 16 + k) * 64]; }
#pragma unroll
                for (int bj = 0; bj < 2; ++bj)
#pragma unroll
                    for (int m = 0; m < 4; ++m) { const int k = (bj * 4 + m) * 2;
                        f32x4 v0 = unpk4(g[k]) * (acc[ai][bj][m][0] * (1.0f / 512.0f)), v1 = unpk4(g[k + 1]) * (acc[ai][bj][m][1] * (1.0f / 512.0f));
                        if (mode != 1) { v0 += unpk4(t[k]); v1 += unpk4(t[k + 1]); }
                        if (mode != 3) { tm[(ai * 16 + k) * 64] = pk4(v0); tm[(ai * 16 + k + 1) * 64] = pk4(v1); }
                        else { u32x2 w; w.x = pk_fp8x4(v0[0] * 16.f, v0[1] * 16.f, v0[2] * 16.f, v0[3] * 16.f); w.y = pk_fp8x4(v1[0] * 16.f, v1[1] * 16.f, v1[2] * 16.f, v1[3] * 16.f);
                               *(u32x2*)((unsigned char*)O + (size_t)(row0 + ai * HALF + m * 16) * DM + col0 + bj * HALF) = w; } }
                asm volatile("" ::: "memory");
            }
        }
    }
};
struct EpiOut {
    static constexpr bool PERM = false;
    const float* xp; const float* xs; float* out; bf16_t* x1b; float* ssq; float sc;
    __device__ __forceinline__ void operator()(const f32x4 (&acc)[2][2][4][2], const Unit& u, int wr, int wc, int fr, int fq) const {
        const int row0 = u.pm * BM + wr * 64 + fr, col0 = u.pn * BM + wc * 32 + 4 * fq;
#pragma unroll
        for (int ai = 0; ai < 2; ++ai)
#pragma unroll
            for (int m = 0; m < 4; ++m) { const int row = row0 + ai * HALF + m * 16;
                const float* xr = (row < TP ? xp + (size_t)row * DM : xs + (size_t)(row - TP) * DM) + col0;
                bf16_t* brow = x1b + (size_t)row * DM + col0; float ss = 0.f;
#pragma unroll
                for (int bj = 0; bj < 2; ++bj)
#pragma unroll
                    for (int n = 0; n < 2; ++n) { const int co = bj * HALF + n * 16; const f32x4 v = *(const f32x4*)(xr + co) + acc[ai][bj][m][n] * sc;
                        u32x2 w; w.x = pk2(v[0], v[1]); w.y = pk2(v[2], v[3]); *(u32x2*)(brow + co) = w;
                        ss += (v[0] * v[0] + v[1] * v[1]) + (v[2] * v[2] + v[3] * v[3]); }
                ss += __shfl_xor(ss, 16); ss += __shfl_xor(ss, 32);
                if (fq == 0) ssq[(size_t)row * 16 + u.pn * 4 + wc] = ss; }
    }
};
struct EpiDownNorm {
    static constexpr bool PERM = false;
    float* out; const bf16_t* x1b; float* xbuf; unsigned* cnt; const float* gf;
    __device__ __forceinline__ void operator()(f32x4 (&acc)[2][2][4][2], const Unit& u, int wr, int wc, int fr, int fq) const {
        const int row0 = u.pm * BM + wr * 64 + fr, col0 = u.pn * BM + wc * 32 + 4 * fq;
#pragma unroll
        for (int ai = 0; ai < 2; ++ai)
#pragma unroll
            for (int m = 0; m < 4; ++m) { const int row = row0 + ai * HALF + m * 16; const bf16_t* orow = x1b + (size_t)row * DM + col0; float ss = 0.f;
#pragma unroll
                for (int bj = 0; bj < 2; ++bj)
#pragma unroll
                    for (int n = 0; n < 2; ++n) { const f32x4 v = unpk4(*(const u32x2*)(orow + bj * HALF + n * 16)) + acc[ai][bj][m][n]; acc[ai][bj][m][n] = v;
                        ss += (v[0] * v[0] + v[1] * v[1]) + (v[2] * v[2] + v[3] * v[3]); }
                ss += __shfl_xor(ss, 16); ss += __shfl_xor(ss, 32);
                if (fq == 0) __hip_atomic_store(xbuf + (size_t)row * 16 + u.pn * 4 + wc, ss, __ATOMIC_RELAXED, __HIP_MEMORY_SCOPE_AGENT);
                if (m == 3) asm volatile("" ::: "memory"); }
        asm volatile("s_waitcnt vmcnt(0)" ::: "memory");
        unsigned* c = cnt + u.pm * 16;
        if (fr == 0 && fq == 0) __hip_atomic_fetch_add(c, 1u, __ATOMIC_RELAXED, __HIP_MEMORY_SCOPE_AGENT);
        while (__hip_atomic_load(c, __ATOMIC_RELAXED, __HIP_MEMORY_SCOPE_AGENT) < 32u) __builtin_amdgcn_s_sleep(1);
        asm volatile("" ::: "memory");
#pragma unroll
        for (int ai = 0; ai < 2; ++ai)
#pragma unroll
            for (int m = 0; m < 4; ++m) { const int row = row0 + ai * HALF + m * 16; float* orow = out + (size_t)row * DM + col0;
                const unsigned long long* sp = (const unsigned long long*)(xbuf + (size_t)row * 16 + 4 * fq);
                const unsigned long long qa = __hip_atomic_load(sp, __ATOMIC_RELAXED, __HIP_MEMORY_SCOPE_AGENT), qb = __hip_atomic_load(sp + 1, __ATOMIC_RELAXED, __HIP_MEMORY_SCOPE_AGENT);
                float t = (__uint_as_float((unsigned)qa) + __uint_as_float((unsigned)(qa >> 32))) + (__uint_as_float((unsigned)qb) + __uint_as_float((unsigned)(qb >> 32)));
                t += __shfl_xor(t, 16); t += __shfl_xor(t, 32);
                const float rs = rsqrtf(t * (1.0f / DM) + EPS);
#pragma unroll
                for (int bj = 0; bj < 2; ++bj)
#pragma unroll
                    for (int n = 0; n < 2; ++n) { const int co = bj * HALF + n * 16; const f32x4 g = *(const f32x4*)(gf + col0 + co); *(f32x4*)(orow + co) = acc[ai][bj][m][n] * rs * g; } }
    }
};

template <class Epi, class SchedT, bool ALIGN_EPI, bool SP2, bool FP8 = false>
__device__ __forceinline__ void gemm_phase(LAS unsigned char* lds, const Gemm g, const SchedT& S, const Epi& E, const int wid) {
    const int lane = lane_id(), tid = wid * 64 + lane, wr = wid >> 2, wc = wid & 3, fr = lane & 15, fq = lane >> 4;
    unsigned voffA[2], voffB[2];
#pragma unroll
    for (int i = 0; i < 2; ++i) { int R, C; stage_rc(tid * 16 + i * 8192, R, C); const int Rb = Epi::PERM ? ((R & ~31) + perm32(R & 31)) : R;
        voffA[i] = (unsigned)(R * g.lda + C) * 2u; voffB[i] = (unsigned)(Rb * g.ldb + C) * 2u; }
    const size_t kstep = (size_t)(BK * 2);
    const size_t hstepA = (size_t)HALF * g.lda * 2, hstepB = (size_t)HALF * g.ldb * 2;
    const size_t tstepA = 2 * hstepA, tstepB = 2 * hstepB;
    const unsigned ldsw = (unsigned)wid * 1024u;
    const int aoff = FP8 ? lds_byte(wr * 64 + fr, fq * 16) : lds_byte(wr * 64 + fr, fq * 8), boff = FP8 ? lds_byte(wc * 32 + fr, fq * 16) : lds_byte(wc * 32 + fr, fq * 8);
    const int aoff1 = FP8 ? lds_byte(wr * 64 + fr, fq * 16 + 8) : aoff + 1024, boff1 = FP8 ? lds_byte(wc * 32 + fr, fq * 16 + 8) : boff + 1024;
#define PG8_SA(b, h) (((b) * 2 + (h)) * HTB)
#define PG8_SB(b, h) ((4 + (b) * 2 + (h)) * HTB)
#define PG8_STAGE(bufoff, gbase, voff) do { _Pragma("unroll") for (int _i = 0; _i < 2; ++_i) { unsigned vo_ = (voff)[_i]; asm volatile("" : "+v"(vo_));     \
        __builtin_amdgcn_global_load_lds((const unsigned*)((const char*)(gbase) + vo_), (LAS unsigned*)(lds + (bufoff) + ldsw + _i * 8192), 16, 0, 0); } } while (0)
#define PG8_CAT(lo, hi) __builtin_bit_cast(v8i_t, __builtin_shufflevector(lo, hi, 0, 1, 2, 3, 4, 5, 6, 7, 8, 9, 10, 11, 12, 13, 14, 15))
#define PG8_LD8(base, off0, off1, g) PG8_CAT(*(const LAS bf16x8*)(lds + (base) + (off0) + (g) * 2048), *(const LAS bf16x8*)(lds + (base) + (off0) + 16 + (g) * 2048))
#define PG8_LDA(dst, b, h) do { if constexpr (FP8) { _Pragma("unroll") for (int m = 0; m < 4; ++m) dst##8[m] = PG8_LD8(PG8_SA(b, h), aoff, aoff1, m); } \
        else { _Pragma("unroll") for (int m = 0; m < 4; ++m) _Pragma("unroll") for (int k = 0; k < 2; ++k) dst[m][k] = *(const LAS bf16x8*)(lds + PG8_SA(b, h) + (k ? aoff1 : aoff) + m * 2048); } } while (0)
#define PG8_LDB(dst, b, h) do { if constexpr (FP8) { dst##8[0] = PG8_LD8(PG8_SB(b, h), boff, boff1, 0); dst##8[1] = PG8_LD8(PG8_SB(b, h), boff, boff1, 1); } \
        else { _Pragma("unroll") for (int n = 0; n < 2; ++n) _Pragma("unroll") for (int k = 0; k < 2; ++k) dst[n][k] = *(const LAS bf16x8*)(lds + PG8_SB(b, h) + (k ? boff1 : boff) + n * 2048); } } while (0)
#define PG8_F8(a_, b_, c_) __builtin_amdgcn_mfma_scale_f32_16x16x128_f8f6f4(a_, b_, c_, 0, 0, 0, 127, 0, 127)
#define PG8_MMA2(ai, b, h) do { __builtin_amdgcn_s_setprio(1); \
        _Pragma("unroll") for (int mm = 0; mm < 2; ++mm) _Pragma("unroll") for (int n = 0; n < 2; ++n) { acc[ai][0][mm][n] = PG8_F8(B08[n], At8[mm], acc[ai][0][mm][n]); acc[ai][1][mm][n] = PG8_F8(B18[n], At8[mm], acc[ai][1][mm][n]); } \
        At8[0] = PG8_LD8(PG8_SA(b, h), aoff, aoff1, 2); At8[1] = PG8_LD8(PG8_SA(b, h), aoff, aoff1, 3); PG8_WAIT_L(0); \
        _Pragma("unroll") for (int mm = 0; mm < 2; ++mm) _Pragma("unroll") for (int n = 0; n < 2; ++n) { acc[ai][0][2 + mm][n] = PG8_F8(B08[n], At8[mm], acc[ai][0][2 + mm][n]); acc[ai][1][2 + mm][n] = PG8_F8(B18[n], At8[mm], acc[ai][1][2 + mm][n]); } \
        PG8_WAIT_L(0); __builtin_amdgcn_s_setprio(0); } while (0)
#define PG8_MMA2S(ai, b, h, STG) do { __builtin_amdgcn_s_setprio(1); \
        _Pragma("unroll") for (int mm = 0; mm < 2; ++mm) _Pragma("unroll") for (int n = 0; n < 2; ++n) { acc[ai][0][mm][n] = PG8_F8(B08[n], At8[mm], acc[ai][0][mm][n]); acc[ai][1][mm][n] = PG8_F8(B18[n], At8[mm], acc[ai][1][mm][n]); } \
        At8[0] = PG8_LD8(PG8_SA(b, h), aoff, aoff1, 2); At8[1] = PG8_LD8(PG8_SA(b, h), aoff, aoff1, 3); PG8_WAIT_L(0); PG8_SCHED; STG; \
        _Pragma("unroll") for (int mm = 0; mm < 2; ++mm) _Pragma("unroll") for (int n = 0; n < 2; ++n) { acc[ai][0][2 + mm][n] = PG8_F8(B08[n], At8[mm], acc[ai][0][2 + mm][n]); acc[ai][1][2 + mm][n] = PG8_F8(B18[n], At8[mm], acc[ai][1][2 + mm][n]); } \
        __builtin_amdgcn_s_setprio(0); } while (0)
#define PG8_MMA(ai, bj, At, Bt) do { __builtin_amdgcn_s_setprio(1); _Pragma("unroll") for (int m = 0; m < 4; ++m) _Pragma("unroll") for (int n = 0; n < 2; ++n) _Pragma("unroll") for (int k = 0; k < 2; ++k) \
        acc[ai][bj][m][n] = __builtin_amdgcn_mfma_f32_16x16x32_bf16(Bt[n][k], At[m][k], acc[ai][bj][m][n], 0, 0, 0); __builtin_amdgcn_s_setprio(0); } while (0)
#define PG8_MMAP(ai, b, h) do { if constexpr (FP8) { __builtin_amdgcn_s_setprio(1); \
        _Pragma("unroll") for (int m = 0; m < 4; ++m) _Pragma("unroll") for (int n = 0; n < 2; ++n) { acc[ai][0][m][n] = PG8_F8(B08[n], At8[m], acc[ai][0][m][n]); acc[ai][1][m][n] = PG8_F8(B18[n], At8[m], acc[ai][1][m][n]); } \
        __builtin_amdgcn_s_setprio(0); } else { PG8_MMA(ai, 0, At, B0); PG8_MMA(ai, 1, At, B1); } } while (0)
#define PG8_WAIT_V(n) asm volatile("s_waitcnt vmcnt(" #n ")" ::: "memory")
#define PG8_WAIT_L(n) asm volatile("s_waitcnt lgkmcnt(" #n ")" ::: "memory")
#define PG8_BAR __builtin_amdgcn_s_barrier()
#define PG8_SCHED __builtin_amdgcn_sched_barrier(0)
    Unit cur, nxt; int ui = 0;
    if (!S.next(0, cur)) return;
    f32x4 acc[2][2][4][2];
#pragma unroll
    for (int a = 0; a < 2; ++a)
#pragma unroll
        for (int b = 0; b < 2; ++b)
#pragma unroll
            for (int m = 0; m < 4; ++m)
#pragma unroll
                for (int n = 0; n < 2; ++n) acc[a][b][m][n] = (f32x4){0.f, 0.f, 0.f, 0.f};
    bf16x8 At[4][2], B0[2][2], B1[2][2];
    v8i_t At8[4], B08[2], B18[2];
    const char* cA = (const char*)g.A + (size_t)cur.pm * tstepA + (size_t)cur.aoff * 2; const char* cB = (const char*)g.Bt + (size_t)cur.pn * tstepB + (size_t)cur.boff * 2;
    if constexpr (SP2) {
        PG8_STAGE(PG8_SB(0, 0), cB, voffB); PG8_STAGE(PG8_SB(0, 1), cB + hstepB, voffB); PG8_STAGE(PG8_SA(0, 0), cA, voffA); PG8_STAGE(PG8_SA(0, 1), cA + hstepA, voffA);
        if (wr == 1) PG8_BAR;
        PG8_WAIT_V(2); PG8_BAR;
        PG8_STAGE(PG8_SB(1, 0), cB + kstep, voffB); PG8_STAGE(PG8_SA(1, 0), cA + kstep, voffA); PG8_STAGE(PG8_SB(1, 1), cB + hstepB + kstep, voffB);
        PG8_WAIT_V(6); PG8_BAR;
    } else {
        PG8_STAGE(PG8_SB(0, 0), cB, voffB); PG8_STAGE(PG8_SA(0, 0), cA, voffA); PG8_STAGE(PG8_SB(0, 1), cB + hstepB, voffB); PG8_STAGE(PG8_SA(0, 1), cA + hstepA, voffA);
        if (wr == 1) PG8_BAR;
        PG8_WAIT_V(4); PG8_BAR;
        PG8_STAGE(PG8_SB(1, 0), cB + kstep, voffB); PG8_STAGE(PG8_SA(1, 0), cA + kstep, voffA); PG8_STAGE(PG8_SB(1, 1), cB + hstepB + kstep, voffB);
        PG8_WAIT_V(6); PG8_BAR;
    }
    for (;;) {
        const bool has_next = S.next(ui + 1, nxt);
        const char* nA = has_next ? (const char*)g.A + (size_t)nxt.pm * tstepA + (size_t)nxt.aoff * 2 : cA; const char* nB = has_next ? (const char*)g.Bt + (size_t)nxt.pn * tstepB + (size_t)nxt.boff * 2 : cB;
        const int nt = cur.nt;
        for (int t = 0; t < nt; t += 2) {
            const bool last = (t == nt - 2);
            const char* a1 = cA + (size_t)(t + 1) * kstep;
            const char* a2 = last ? nA : cA + (size_t)(t + 2) * kstep; const char* b2 = last ? nB : cB + (size_t)(t + 2) * kstep;
            const char* a3 = a2 + kstep; const char* b3 = b2 + kstep;
            if constexpr (SP2) {
#define PG8_S1 PG8_STAGE(PG8_SA(1, 1), a1 + hstepA, voffA)
#define PG8_S2 do { PG8_STAGE(PG8_SB(0, 0), b2, voffB); PG8_STAGE(PG8_SB(0, 1), b2 + hstepB, voffB); PG8_STAGE(PG8_SA(0, 0), a2, voffA); } while (0)
#define PG8_S3 PG8_STAGE(PG8_SA(0, 1), a2 + hstepA, voffA)
#define PG8_S4 do { PG8_STAGE(PG8_SB(1, 0), b3, voffB); PG8_STAGE(PG8_SB(1, 1), b3 + hstepB, voffB); PG8_STAGE(PG8_SA(1, 0), a3, voffA); } while (0)
            PG8_LDB(B0, 0, 0); PG8_LDB(B1, 0, 1); PG8_SCHED; PG8_LDA(At, 0, 0); PG8_S1;
            PG8_WAIT_V(8); PG8_WAIT_L(0); PG8_BAR; PG8_MMAP(0, 0, 0); PG8_BAR; PG8_SCHED;
            PG8_LDA(At, 0, 1); PG8_S2;
            PG8_WAIT_V(8); PG8_WAIT_L(0); PG8_BAR; PG8_MMAP(1, 0, 1); PG8_BAR; PG8_SCHED;
            PG8_LDB(B0, 1, 0); PG8_LDB(B1, 1, 1); PG8_SCHED; PG8_LDA(At, 1, 0); PG8_S3;
            PG8_WAIT_V(8); PG8_WAIT_L(0); PG8_BAR; PG8_MMAP(0, 1, 0); PG8_BAR; PG8_SCHED;
            PG8_LDA(At, 1, 1); PG8_S4;
            PG8_WAIT_V(8); PG8_WAIT_L(0); PG8_BAR; PG8_MMAP(1, 1, 1); PG8_BAR; PG8_SCHED;
            } else {
            PG8_LDB(B0, 0, 0); PG8_SCHED; PG8_LDA(At, 0, 0); PG8_STAGE(PG8_SA(1, 1), a1 + hstepA, voffA);
            PG8_WAIT_L(8); PG8_BAR; PG8_WAIT_L(0); PG8_MMA(0, 0, At, B0); PG8_BAR; PG8_SCHED;
            PG8_LDB(B1, 0, 1); PG8_STAGE(PG8_SB(0, 0), b2, voffB);
            PG8_BAR; PG8_WAIT_L(0); PG8_MMA(0, 1, At, B1); PG8_BAR;
            PG8_LDA(At, 0, 1); PG8_STAGE(PG8_SA(0, 0), a2, voffA);
            PG8_BAR; PG8_WAIT_L(0); PG8_MMA(1, 0, At, B0); PG8_BAR; PG8_SCHED;
            PG8_STAGE(PG8_SB(0, 1), b2 + hstepB, voffB);
            PG8_WAIT_V(6); PG8_BAR; PG8_MMA(1, 1, At, B1); PG8_BAR;
            PG8_LDB(B0, 1, 0); PG8_SCHED; PG8_LDA(At, 1, 0); PG8_STAGE(PG8_SA(0, 1), a2 + hstepA, voffA);
            PG8_WAIT_L(8); PG8_BAR; PG8_WAIT_L(0); PG8_MMA(0, 0, At, B0); PG8_BAR; PG8_SCHED;
            PG8_LDB(B1, 1, 1); PG8_STAGE(PG8_SB(1, 0), b3, voffB);
            PG8_BAR; PG8_WAIT_L(0); PG8_MMA(0, 1, At, B1); PG8_BAR;
            PG8_LDA(At, 1, 1); PG8_STAGE(PG8_SA(1, 0), a3, voffA);
            PG8_BAR; PG8_WAIT_L(0); PG8_MMA(1, 0, At, B0); PG8_BAR; PG8_SCHED;
            PG8_STAGE(PG8_SB(1, 1), b3 + hstepB, voffB);
            PG8_WAIT_V(6); PG8_BAR; PG8_MMA(1, 1, At, B1); PG8_BAR;
            }
        }
        if constexpr (ALIGN_EPI) { if (wr == 0) PG8_BAR; }
        { const int l2_ = lane_id(); E(acc, cur, wr, wc, l2_ & 15, l2_ >> 4); }
        if (!has_next) break;
#pragma unroll
        for (int a = 0; a < 2; ++a)
#pragma unroll
            for (int b = 0; b < 2; ++b)
#pragma unroll
                for (int m = 0; m < 4; ++m)
#pragma unroll
                    for (int n = 0; n < 2; ++n) acc[a][b][m][n] = (f32x4){0.f, 0.f, 0.f, 0.f};
        cur = nxt; cA = nA; cB = nB; ++ui;
        if constexpr (ALIGN_EPI) { if (wr == 1) PG8_BAR; }
    }
    PG8_WAIT_V(0);
    if constexpr (!ALIGN_EPI) { if (wr == 0) PG8_BAR; }
    PG8_BAR;
#undef PG8_SA
#undef PG8_SB
#undef PG8_STAGE
#undef PG8_LDA
#undef PG8_CAT
#undef PG8_LD8
#undef PG8_F8
#undef PG8_MMA2
#undef PG8_MMA2S
#undef PG8_S1
#undef PG8_S2
#undef PG8_S3
#undef PG8_S4
#undef PG8_MMAP
#undef PG8_LDB
#undef PG8_MMA
#undef PG8_WAIT_V
#undef PG8_WAIT_L
#undef PG8_BAR
#undef PG8_SCHED
}
}

#define MFMA32(a, b, c) __builtin_amdgcn_mfma_f32_32x32x16_bf16((a), (b), (c), 0, 0, 0)
__device__ __forceinline__ s16x4 vtr(LAS const char* p) { return __builtin_bit_cast(s16x4, __builtin_amdgcn_ds_read_tr16_b64_v4i16((LAS v4i16_t*)p)); }
__device__ __forceinline__ int crow(int r, int hi) { return (r & 3) + 8 * (r >> 2) + 4 * hi; }
constexpr int ALDS_K = 0, ALDS_V = 65536, ALDS_BIAS = 131072;

struct UDesc {
    int type;
    const bf16_t* qp; const bf16_t* kp; const bf16_t* vp;
    long tstride, sstride;
    int nh, Ld, q0, QB, HALF, nsub;
    const float* bias;
    const float* sink;
    bf16_t* op; long o_tstride, o_sstride;
    float* lsep; long l_tstride, l_sstride;
};
__device__ __forceinline__ void stage_issue(const UDesc& d, const int wave, u32x4 (&kr)[8], u32x4 (&vr)[8], float (&bv)[3]) {
    const int tid = wave * 64 + lane_id();
    if (d.type == 0) {
        const int c = tid & 15;
#pragma unroll
        for (int j = 0; j < 8; ++j) { const size_t off = (size_t)(j * 32 + (tid >> 4)) * 1024 + c * 8; kr[j] = *(const u32x4*)(d.kp + off); vr[j] = *(const u32x4*)(d.vp + off); }
    } else {
        const int c = tid & 7, NK = d.QB + 2 * d.HALF, nb = d.nh * (2 * d.HALF + 64);
#pragma unroll
        for (int j = 0; j < 8; ++j) { const int r = j * 64 + (tid >> 3); int sub = r / NK; const int i = r - sub * NK; sub = sub < d.nsub ? sub : d.nsub - 1;
            int idx = d.q0 - d.HALF + i; idx = idx < 0 ? 0 : (idx >= d.Ld ? d.Ld - 1 : idx);
            const size_t off = (size_t)sub * d.sstride + (size_t)idx * d.tstride + c * 8;
            kr[j] = *(const u32x4*)(d.kp + off); vr[j] = *(const u32x4*)(d.vp + off); }
#pragma unroll
        for (int t = 0; t < 3; ++t) { const int i = tid + 512 * t; bv[t] = d.bias[i < nb ? i : nb - 1]; }
    }
}
__device__ __forceinline__ void stage_commit(const UDesc& d, LAS char* lds, const int wave, const u32x4 (&kr)[8], const u32x4 (&vr)[8], const float (&bv)[3]) {
    const int tid = wave * 64 + lane_id();
    LAS char* Kl = lds + ALDS_K; LAS char* Vl = lds + ALDS_V;
    if (d.type == 0) {
        const int c = tid & 15;
#pragma unroll
        for (int j = 0; j < 8; ++j) { const int r = j * 32 + (tid >> 4);
            *(LAS u32x4*)(Kl + r * 256 + ((c ^ (r & 15)) << 4)) = kr[j];
            *(LAS u32x4*)(Vl + (c >> 2) * 16384 + r * 64 + (c & 3) * 16) = vr[j]; }
    } else {
        const int c = tid & 7, nb = d.nh * (2 * d.HALF + 64);
#pragma unroll
        for (int j = 0; j < 8; ++j) { const int r = j * 64 + (tid >> 3);
            *(LAS u32x4*)(Kl + r * 128 + ((c ^ ((r >> 1) & 7)) << 4)) = kr[j];
            *(LAS u32x4*)(Vl + (c >> 2) * 32768 + r * 64 + (c & 3) * 16) = vr[j]; }
        LAS float* Bl = (LAS float*)(lds + ALDS_BIAS);
#pragma unroll
        for (int t = 0; t < 3; ++t) { const int i = tid + 512 * t; if (i < nb) Bl[i] = bv[t]; }
        if (tid < 64) ((LAS float*)(lds + ALDS_BIAS + 6144))[tid] = -1e30f;
    }
}

__device__ __forceinline__ unsigned cvtpk(float lo, float hi) { f32x2_t v = {lo, hi}; bf16x2_t b = __builtin_convertvector(v, bf16x2_t); return __builtin_bit_cast(unsigned, b); }
__device__ __forceinline__ float xhalf_max(float v) { auto rr = __builtin_amdgcn_permlane32_swap(__float_as_uint(v), __float_as_uint(v), false, false); return fmaxf(__uint_as_float(rr[0]), __uint_as_float(rr[1])); }
__device__ __forceinline__ float xhalf_sum(float v) { auto rr = __builtin_amdgcn_permlane32_swap(__float_as_uint(v), __float_as_uint(v), false, false); return __uint_as_float(rr[0]) + __uint_as_float(rr[1]); }
__device__ __forceinline__ float max16(const f32x16& p) {
    float a = fmaxf(fmaxf(p[0], p[1]), p[2]), b = fmaxf(fmaxf(p[3], p[4]), p[5]);
    a = fmaxf(fmaxf(a, p[6]), p[7]); b = fmaxf(fmaxf(b, p[8]), p[9]); a = fmaxf(fmaxf(a, p[10]), p[11]); b = fmaxf(fmaxf(b, p[12]), p[13]);
    a = fmaxf(fmaxf(a, p[14]), p[15]); return fmaxf(a, b);
}
constexpr int ALDS_NEG = ALDS_BIAS + 6144;
template <int NKT, int DH, bool HASB>
__device__ __forceinline__ void attn_scores(LAS const char* Kl, const int krow0, LAS const float* bl, LAS const float* negl, const int kt_lo, const int kt_hi,
                                            const bf16x8 (&qf)[DH], const int h, f32x16 (&S)[NKT]) {
    const int sw = DH == 4 ? ((krow0 >> 1) & 7) : (krow0 & 15);
    LAS const char* kbase[DH];
#pragma unroll
    for (int d0 = 0; d0 < DH; ++d0) kbase[d0] = Kl + krow0 * (DH * 32) + (((2 * d0 + h) ^ sw) << 4);
    constexpr int KTS = 32 * DH * 32;
    constexpr bool PF = (DH == 4);
    bf16x8 kf[DH], kfn[DH];
#pragma unroll
    for (int d0 = 0; d0 < DH; ++d0) kf[d0] = *(LAS const bf16x8*)(kbase[d0]);
    if (HASB) { LAS const float* bt = (0 >= kt_lo && 0 < kt_hi) ? bl : negl;
#pragma unroll
        for (int i = 0; i < 16; ++i) S[0][i] = bt[(i & 3) + 8 * (i >> 2)]; }
    else {
#pragma unroll
        for (int i = 0; i < 16; ++i) S[0][i] = 0.f; }
#pragma unroll
    for (int kt = 0; kt < NKT; ++kt) {
        if (!PF && kt > 0) {
#pragma unroll
            for (int d0 = 0; d0 < DH; ++d0) kf[d0] = *(LAS const bf16x8*)(kbase[d0] + kt * KTS);
        }
        if (!PF) __builtin_amdgcn_sched_barrier(0);
        if (kt + 1 < NKT) {
            if (PF) {
#pragma unroll
                for (int d0 = 0; d0 < DH; ++d0) kfn[d0] = *(LAS const bf16x8*)(kbase[d0] + (kt + 1) * KTS);
            }
            if (HASB) { LAS const float* bt = (kt + 1 >= kt_lo && kt + 1 < kt_hi) ? bl + 32 * (kt + 1) : negl;
#pragma unroll
                for (int i = 0; i < 16; ++i) S[kt + 1][i] = bt[(i & 3) + 8 * (i >> 2)]; }
            else {
#pragma unroll
                for (int i = 0; i < 16; ++i) S[kt + 1][i] = 0.f; }
        }
#pragma unroll
        for (int d0 = 0; d0 < DH; ++d0) S[kt] = MFMA32(kf[d0], qf[d0], S[kt]);
        if (PF && kt + 1 < NKT) {
#pragma unroll
            for (int d0 = 0; d0 < DH; ++d0) kf[d0] = kfn[d0];
        }
        asm volatile("" : "+v"(S[kt]) :: "memory");
        __builtin_amdgcn_sched_barrier(0);
    }
}
template <int NKT, int DH>
__device__ __forceinline__ void attn_finish(f32x16 (&S)[NKT], LAS const char* Vl, const int vrow0, const int vplane, const float sinkv, const bool has_sink, const int lane,
                                            f32x16 (&o)[DH / 2], float& scale_out, float& lse_out) {
    const int h = lane >> 5;
    float mx = max16(S[0]);
#pragma unroll
    for (int kt = 1; kt < NKT; ++kt) mx = fmaxf(mx, max16(S[kt]));
    mx = xhalf_max(mx);
    if (has_sink) mx = fmaxf(mx, sinkv);
    float l = 0.f;
    u32x4 pw[NKT][2];
#pragma unroll
    for (int kt = 0; kt < NKT; ++kt) {
        float ls = 0.f;
#pragma unroll
        for (int i = 0; i < 16; ++i) { S[kt][i] = __builtin_amdgcn_exp2f(S[kt][i] - mx); ls += S[kt][i]; }
        l += ls;
#pragma unroll
        for (int q = 0; q < 4; ++q) { pw[kt][0][q] = cvtpk(S[kt][2 * q], S[kt][2 * q + 1]); pw[kt][1][q] = cvtpk(S[kt][8 + 2 * q], S[kt][9 + 2 * q]); }
        asm volatile("" : "+v"(pw[kt][0]), "+v"(pw[kt][1]), "+v"(l));
        __builtin_amdgcn_sched_barrier(0);
    }
#pragma unroll
    for (int db = 0; db < DH / 2; ++db)
#pragma unroll
        for (int i = 0; i < 16; ++i) o[db][i] = 0.f;
    LAS const char* vb = Vl + (vrow0 + 4 * h + ((lane & 15) >> 2)) * 64 + ((lane >> 4) & 1) * 32 + (lane & 3) * 8;
    s16x4 va[DH / 2][4], vn[DH / 2][4];
#pragma unroll
    for (int db = 0; db < DH / 2; ++db)
#pragma unroll
        for (int q = 0; q < 4; ++q) va[db][q] = vtr(vb + db * vplane + q * 512);
    __builtin_amdgcn_sched_barrier(0);
#pragma unroll
    for (int kt = 0; kt < NKT; ++kt) {
        if (kt + 1 < NKT) {
#pragma unroll
            for (int db = 0; db < DH / 2; ++db)
#pragma unroll
                for (int q = 0; q < 4; ++q) vn[db][q] = vtr(vb + (kt + 1) * 2048 + db * vplane + q * 512);
        }
        const bf16x8 pb0 = __builtin_bit_cast(bf16x8, pw[kt][0]), pb1 = __builtin_bit_cast(bf16x8, pw[kt][1]);
#pragma unroll
        for (int db = 0; db < DH / 2; ++db) {
            o[db] = MFMA32(__builtin_shufflevector(va[db][0], va[db][1], 0, 1, 2, 3, 4, 5, 6, 7), pb0, o[db]);
            o[db] = MFMA32(__builtin_shufflevector(va[db][2], va[db][3], 0, 1, 2, 3, 4, 5, 6, 7), pb1, o[db]);
        }
#pragma unroll
        for (int db = 0; db < DH / 2; ++db)
#pragma unroll
            for (int q = 0; q < 4; ++q) va[db][q] = vn[db][q];
#pragma unroll
        for (int db = 0; db < DH / 2; ++db) asm volatile("" : "+v"(o[db]) :: "memory");
        __builtin_amdgcn_sched_barrier(0);
    }
    l = xhalf_sum(l);
    if (has_sink) l += __builtin_amdgcn_exp2f(sinkv - mx);
    scale_out = 1.0f / l; lse_out = mx + __builtin_amdgcn_logf(l);
}
constexpr int ALDS_OST = 139264;
template <int NDB>
__device__ __forceinline__ void store_o_tile(LAS char* stg, const f32x16 (&o)[NDB], const float scale, bf16_t* tile_base, const long row_stride, const int lane) {
    const int ql = lane & 31, h = lane >> 5;
    LAS char* wp = stg + ql * 64 + 8 * h; const int wsw = (ql >> 1) & 3;
    const int r0 = lane >> 2, c = lane & 3;
#pragma unroll
    for (int db = 0; db < NDB; ++db) {
#pragma unroll
        for (int g4 = 0; g4 < 4; ++g4) { u32x2 w; w.x = cvtpk(o[db][4 * g4] * scale, o[db][4 * g4 + 1] * scale); w.y = cvtpk(o[db][4 * g4 + 2] * scale, o[db][4 * g4 + 3] * scale);
            *(LAS u32x2*)(wp + ((g4 ^ wsw) << 4)) = w; }
#pragma unroll
        for (int t = 0; t < 2; ++t) { const int r = t * 16 + r0; const u32x4 v = *(LAS const u32x4*)(stg + r * 64 + ((c ^ ((r >> 1) & 3)) << 4));
            *(u32x4*)(tile_base + (size_t)r * row_stride + db * 32 + c * 8) = v; }
    }
}
template <int NDB>
__device__ __forceinline__ void store_o_tile8(LAS char* stg, const f32x16 (&o)[NDB], const float scale, unsigned char* tile_base8, const long row_stride, const int lane) {
    const int ql = lane & 31, h = lane >> 5;
    LAS char* wp = stg + ql * 32 + 4 * h;
    const int r = lane >> 1, hf = lane & 1;
    const float s16 = scale * 16.0f;
#pragma unroll
    for (int db = 0; db < NDB; ++db) {
#pragma unroll
        for (int g4 = 0; g4 < 4; ++g4) *(LAS unsigned*)(wp + 8 * g4) = pk_fp8x4(o[db][4 * g4] * s16, o[db][4 * g4 + 1] * s16, o[db][4 * g4 + 2] * s16, o[db][4 * g4 + 3] * s16);
        const u32x4 v = *(LAS const u32x4*)(stg + r * 32 + hf * 16);
        *(u32x4*)(tile_base8 + (size_t)r * row_stride + db * 32 + hf * 16) = v;
    }
}
__device__ __forceinline__ const bf16_t* band_qrow(const UDesc& d, int wt, int ql, int h) {
    const int nq32 = d.QB >> 5; const int sub = wt / (d.nh * nq32), rem = wt - sub * (d.nh * nq32), hh = rem / nq32, qs = (rem - hh * nq32) * 32;
    return d.qp + (size_t)sub * d.sstride + (size_t)(d.q0 + qs + ql) * d.tstride + hh * 64 + 8 * h;
}
template <int NKT, bool OUT8>
__device__ __forceinline__ void band_compute(LAS char* lds, const UDesc& d, const int wave, bf16x8 (&qf)[4]) {
    const int lane = lane_id(), ql = lane & 31, h = lane >> 5;
    const int NK = d.QB + 2 * d.HALF, nbx = 2 * d.HALF + 64;
    LAS char* Kl = lds + ALDS_K; LAS char* Vl = lds + ALDS_V; LAS float* Bl = (LAS float*)(lds + ALDS_BIAS); LAS const float* negl = (LAS const float*)(lds + ALDS_NEG);
    const int nq32 = d.QB >> 5, ntiles = d.nsub * d.nh * nq32, nkt = (32 + 2 * d.HALF) >> 5;
    for (int wt = wave; wt < ntiles; wt += 8) {
        const int sub = wt / (d.nh * nq32), rem = wt - sub * (d.nh * nq32), hh = rem / nq32, qs = (rem - hh * nq32) * 32;
        const int qidx = d.q0 + qs + ql;
        LAS const float* bl = Bl + hh * nbx + 32 - ql + 4 * h;
        const int rbase = sub * NK;
        const int k0 = d.q0 - d.HALF + qs;
        int kt_lo = k0 < 0 ? (-k0) >> 5 : 0, kt_hi = (d.Ld - k0) >> 5; kt_hi = kt_hi < nkt ? kt_hi : nkt;
        f32x16 o[2]; float scale, lse2;
        const bool has_sink = d.sink != nullptr; const float sinkv = has_sink ? d.sink[hh] * 1.4426950408889634f : 0.f;
        const bf16_t* qnrow = band_qrow(d, wt + 8 < ntiles ? wt + 8 : wt, ql, h);
        { f32x16 S[NKT]; attn_scores<NKT, 4, true>(Kl, rbase + qs + ql, bl, negl, kt_lo, kt_hi, qf, h, S);
#pragma unroll
          for (int d0 = 0; d0 < 4; ++d0) qf[d0] = *(const bf16x8*)(qnrow + 16 * d0);
          attn_finish<NKT, 4>(S, Vl, rbase + qs, 32768, sinkv, has_sink, lane, o, scale, lse2); }
        if (OUT8) store_o_tile8<2>(lds + ALDS_OST + wave * 2048, o, scale, (unsigned char*)d.op + (size_t)sub * d.o_sstride + (size_t)(d.q0 + qs) * d.o_tstride + hh * 64, d.o_tstride, lane);
        else store_o_tile<2>(lds + ALDS_OST + wave * 2048, o, scale, d.op + (size_t)sub * d.o_sstride + (size_t)(d.q0 + qs) * d.o_tstride + hh * 64, d.o_tstride, lane);
        if (d.lsep && h == 0) d.lsep[(size_t)sub * d.l_sstride + (size_t)qidx * d.l_tstride] = lse2;
    }
    __syncthreads();
}

__device__ __forceinline__ void mem_compute(LAS char* lds, const UDesc& d, const int wave, bf16x8 (&qf)[8]) {
    const int lane = lane_id(), ql = lane & 31, h = lane >> 5;
    LAS char* Kl = lds + ALDS_K; LAS char* Vl = lds + ALDS_V;
    for (int wt = wave; wt < 32; wt += 8) {
        const int tok = wt * 32 + ql;
        const bf16_t* qnrow = d.qp + (size_t)((wt + 8 < 32 ? wt + 8 : wt) * 32 + ql) * NQKV + 8 * h;
        f32x16 o[4]; float scale, lse2;
        { f32x16 S[8]; attn_scores<8, 8, false>(Kl, ql, nullptr, nullptr, 0, 8, qf, h, S);
#pragma unroll
          for (int d0 = 0; d0 < 8; ++d0) qf[d0] = *(const bf16x8*)(qnrow + 16 * d0);
          attn_finish<8, 8>(S, Vl, 0, 16384, 0.f, false, lane, o, scale, lse2); }
        store_o_tile8<4>(lds + ALDS_OST + wave * 2048, o, scale, (unsigned char*)d.op + (size_t)(wt * 32) * (LDH * 2), LDH * 2, lane);
    }
    __syncthreads();
}

__device__ __forceinline__ void transpose_item(const float* W, int ldsrc, int c0, int nblk, bf16_t* WT, int ldd, int dcol, const float* g, int scale_mode, LAS float* scr, int item, int lane) {
    const int kb = item / nblk, nbi = item - kb * nblk, k0 = 64 * kb, n0 = 32 * nbi;
    float cs = 1.f;
    if (scale_mode == 1) { const int n = n0; cs = (n < 512 || (n >= 768 && n < 1536)) ? 0.125f * 1.4426950408889634f : (n >= 3072 ? 0.08838834764831845f * 1.4426950408889634f : 1.f); }
#pragma unroll 8
    for (int i = 0; i < 32; ++i) { const int kk = 2 * i + (lane >> 5); float v = W[(size_t)(k0 + kk) * ldsrc + c0 + n0 + (lane & 31)]; if (g) v *= g[k0 + kk]; scr[kk * 33 + (lane & 31)] = v * cs; }
    asm volatile("s_waitcnt lgkmcnt(0)" ::: "memory");
    const int c = lane & 7;
#pragma unroll
    for (int j = 0; j < 4; ++j) { const int n = (lane >> 3) + 8 * j; const LAS float* s = scr + (8 * c) * 33 + n;
        u32x4 o; o.x = pk2(s[0 * 33], s[1 * 33]); o.y = pk2(s[2 * 33], s[3 * 33]); o.z = pk2(s[4 * 33], s[5 * 33]); o.w = pk2(s[6 * 33], s[7 * 33]);
        *(u32x4*)(WT + (size_t)(n0 + n) * ldd + dcol + k0 + 8 * c) = o; }
    asm volatile("s_waitcnt lgkmcnt(0)" ::: "memory");
}
template <int NRW>
__device__ __forceinline__ void rms_rows_to_bf16(const float* const (&xrow)[NRW], bf16_t* const (&orow)[NRW], unsigned char* const (&o8row)[NRW], int lane) {
    f32x4 v[NRW][4];
#pragma unroll
    for (int r = 0; r < NRW; ++r)
#pragma unroll
        for (int j = 0; j < 4; ++j) v[r][j] = ((const f32x4*)xrow[r])[lane + 64 * j];
#pragma unroll
    for (int r = 0; r < NRW; ++r) { float s = 0.f;
#pragma unroll
        for (int j = 0; j < 4; ++j) s += (v[r][j].x * v[r][j].x + v[r][j].y * v[r][j].y) + (v[r][j].z * v[r][j].z + v[r][j].w * v[r][j].w);
        const float rstd = rsqrtf(wave_sum(s) * (1.f / DM) + EPS);
        if (orow[r]) { u32x2* o8 = (u32x2*)orow[r] + lane;
#pragma unroll
            for (int j = 0; j < 4; ++j) { u32x2 w; w.x = pk2(v[r][j].x * rstd, v[r][j].y * rstd); w.y = pk2(v[r][j].z * rstd, v[r][j].w * rstd); o8[64 * j] = w; } }
        if (o8row[r]) { unsigned* q8 = (unsigned*)o8row[r] + lane;
#pragma unroll
            for (int j = 0; j < 4; ++j) q8[64 * j] = pk_fp8x4(v[r][j].x * rstd, v[r][j].y * rstd, v[r][j].z * rstd, v[r][j].w * rstd); } }
}
__device__ __forceinline__ void transpose_item8(const float* W, int ldsrc, int c0, int nblk, unsigned char* W8, const float* g, int scale_mode, float mult, LAS float* scr, int item, int lane, int ldd = 1024, int dcol = 0) {
    const int kb = item / nblk, nbi = item - kb * nblk, k0 = 64 * kb, n0 = 32 * nbi;
    float cs = mult;
    if (scale_mode == 1) { const int n = n0; cs *= (n < 512 || (n >= 768 && n < 1536)) ? 0.125f * 1.4426950408889634f : (n >= 3072 ? 0.08838834764831845f * 1.4426950408889634f : 1.f); }
#pragma unroll 8
    for (int i = 0; i < 32; ++i) { const int kk = 2 * i + (lane >> 5); float v = W[(size_t)(k0 + kk) * ldsrc + c0 + n0 + (lane & 31)]; if (g) v *= g[k0 + kk]; scr[kk * 33 + (lane & 31)] = v * cs; }
    asm volatile("s_waitcnt lgkmcnt(0)" ::: "memory");
    const int c = lane & 7;
#pragma unroll
    for (int j = 0; j < 4; ++j) { const int n = (lane >> 3) + 8 * j; const LAS float* sp = scr + (8 * c) * 33 + n;
        u32x2 o; o.x = pk_fp8x4(sp[0 * 33], sp[1 * 33], sp[2 * 33], sp[3 * 33]); o.y = pk_fp8x4(sp[4 * 33], sp[5 * 33], sp[6 * 33], sp[7 * 33]);
        *(u32x2*)(W8 + (size_t)(n0 + n) * ldd + dcol + k0 + 8 * c) = o; }
    asm volatile("s_waitcnt lgkmcnt(0)" ::: "memory");
}

#ifndef REPMASK
#define REPMASK 0
#endif
#ifndef REPMASK
#define REPMASK 0
#endif
#define XB_TMO      128
#define XB_XCNT(j)  (256  + 64 * (j))
#define XB_XSUB(j)  (1280 + 64 * (j))
#define XB_XGEN(j)  (2304 + 64 * (j))
#define XB_TOP      3328
#define XB_TOPGEN   3392
#define XB_SPIN_CAP (1u << 22)
__device__ __forceinline__ unsigned xb_ld(unsigned* p)              { return __hip_atomic_load(p, __ATOMIC_RELAXED, __HIP_MEMORY_SCOPE_AGENT); }
__device__ __forceinline__ unsigned xb_add(unsigned* p, unsigned v) { return __hip_atomic_fetch_add(p, v, __ATOMIC_RELAXED, __HIP_MEMORY_SCOPE_AGENT); }
__device__ __forceinline__ unsigned xb_xcc_id() { return (unsigned)__builtin_amdgcn_s_getreg((3 << 11) | 20) & 0xFu; }
#define XB_SPIN(cond, bar) do { unsigned _sp = 0; while (cond) { __builtin_amdgcn_s_sleep(1); \
    if ((++_sp & 255u) == 0u) { if (xb_ld(&(bar)[XB_TMO])) break; if (_sp > XB_SPIN_CAP) { atomicAdd(&(bar)[XB_TMO], 1u); break; } } } } while (0)
struct XcdBarrier { unsigned* bar; unsigned x; volatile LAS unsigned* st; };
__device__ __forceinline__ void xcd_barrier_complete(unsigned* bar, unsigned x, unsigned& nloc, unsigned& nx) {
    const unsigned G = gridDim.x;
    unsigned sum, cnt, mine, sp = 0u;
    for (;;) {
        sum = 0u; cnt = 0u; mine = 0u;
#pragma unroll
        for (unsigned j = 0; j < 16; ++j) { const unsigned c = xb_ld(&bar[XB_XCNT(j)]); sum += c; cnt += (c > 0u) ? 1u : 0u; mine = (j == x) ? c : mine; }
        if (sum == G) break;
        __builtin_amdgcn_s_sleep(1);
        if ((++sp & 255u) == 0u) { if (xb_ld(&bar[XB_TMO])) break; if (sp > XB_SPIN_CAP) { atomicAdd(&bar[XB_TMO], 1u); break; } }
    }
    nloc = mine > 0u ? mine : 1u; nx = cnt > 0u ? cnt : 1u;
}
__device__ __forceinline__ void xcd_barrier(const XcdBarrier& b, const int wave) {
    asm volatile("s_waitcnt vmcnt(0)" ::: "memory");
    __syncthreads();
    if (wave == 0 && lane_id() == 0) {
        unsigned* bar = b.bar;
        __builtin_amdgcn_s_waitcnt(0);
        unsigned nloc = b.st[0], nx = b.st[1];
        if (nloc == 0u) { xcd_barrier_complete(bar, b.x, nloc, nx); b.st[0] = nloc; b.st[1] = nx; }
        const unsigned old = xb_add(&bar[XB_XSUB(b.x)], 1u);
        const unsigned gen = old / nloc;
        if (old + 1u == (gen + 1u) * nloc) {
            __builtin_amdgcn_fence(__ATOMIC_RELEASE, "agent");
            asm volatile("s_waitcnt vmcnt(0)" ::: "memory");
            const unsigned og = xb_add(&bar[XB_TOP], 1u);
            const unsigned tg = og / nx;
            if (og + 1u == (tg + 1u) * nx) xb_add(&bar[XB_TOPGEN], 1u);
            else XB_SPIN(xb_ld(&bar[XB_TOPGEN]) == tg, bar);
            __builtin_amdgcn_fence(__ATOMIC_ACQUIRE, "agent");
            xb_add(&bar[XB_XGEN(b.x)], 1u);
            asm volatile("s_waitcnt vmcnt(0)" ::: "memory");
        } else {
            XB_SPIN(xb_ld(&bar[XB_XGEN(b.x)]) == gen, bar);
            __builtin_amdgcn_fence(__ATOMIC_ACQUIRE, "agent");
            asm volatile("s_waitcnt vmcnt(0)" ::: "memory");
        }
    }
    __syncthreads();
}

struct Args { const float* in[18]; float* out; unsigned char* ws; };

__global__ void __launch_bounds__(512, 2) fwd_megakernel(Args args) {
    extern __shared__ __attribute__((aligned(16))) unsigned char lds_raw[];
    LAS unsigned char* lds = (LAS unsigned char*)lds_raw;
    cg::grid_group grid = cg::this_grid();
    const int wave = __builtin_amdgcn_readfirstlane(threadIdx.x >> 6);
    const int G = gridDim.x, bx = blockIdx.x;
    XcdBarrier xbar; xbar.bar = (unsigned*)(args.ws + 32768); xbar.x = xb_xcc_id(); xbar.st = (volatile LAS unsigned*)(lds + 138240);
    if (threadIdx.x == 0) { xbar.st[0] = 0u; xbar.st[1] = 0u; (void)xb_add(&xbar.bar[XB_XCNT(xbar.x)], 1u); }
    unsigned char* ws = args.ws;
    const float* x_p = args.in[0]; const float* x_s = args.in[1]; const float* mem_p = args.in[2]; const float* mem_s = args.in[3];
    const float* rel_bias = args.in[4]; const float* norm1_g = args.in[5]; const float* w_in = args.in[6]; const float* mem_norm_g = args.in[7];
    const float* w_mem_kv = args.in[8]; const float* sink_logit = args.in[9]; const float* w_br_a = args.in[10]; const float* w_br_b = args.in[11];
    const float* w_br_m = args.in[12]; const float* w_out = args.in[13]; const float* norm2_g = args.in[14]; const float* w_up = args.in[15];
    const float* w_down = args.in[16]; const float* final_g = args.in[17];
    float* out = args.out;
    float* biasA = (float*)(ws + WS_BIASA); float* biasB = (float*)(ws + WS_BIASB);
    bf16_t* Wqkv = (bf16_t*)(ws + WS_WQKV); bf16_t* W3 = (bf16_t*)(ws + WS_W3); bf16_t* Wmem = (bf16_t*)(ws + WS_WMEM); bf16_t* Wout = (bf16_t*)(ws + WS_WOUT);
    bf16_t* Wup = (bf16_t*)(ws + WS_WUP); bf16_t* Wdn = (bf16_t*)(ws + WS_WDN);
    bf16_t* memn = (bf16_t*)(ws + WS_MEMN); bf16_t* mkv = (bf16_t*)(ws + WS_MKV); float* ssq = (float*)(ws + WS_SSQ); float* lse = (float*)(ws + WS_LSE);
    bf16_t* qkv = (bf16_t*)(ws + WS_QKV); bf16_t* hcat = (bf16_t*)(ws + WS_HCAT); bf16_t* x1b = (bf16_t*)(ws + WS_X1B); bf16_t* merged = (bf16_t*)(ws + WS_MERGED);
    bf16_t* hid = (bf16_t*)(ws + WS_HID);
    unsigned char* h8 = (unsigned char*)out + 160 * MiB; unsigned char* Wg8 = (unsigned char*)out + 248 * MiB; unsigned char* Wqkv8 = (unsigned char*)out + 252 * MiB;
    bf16_t* og = (bf16_t*)((unsigned char*)out + DO_OG);

    for (int rep_ = 0; rep_ < 1 + ((REPMASK >> 0) & 1); ++rep_) {
        const int lane = lane_id(), tid = wave * 64 + lane;
        LAS float* scr = (LAS float*)(lds + wave * 16384);
        const int gw = bx * 8 + wave, NGW = G * 8;
        constexpr int I1 = 16 * 112, I2 = 16 * 32, I3 = 8 * 32, I4 = 4 * 32, I6 = 16 * 32, I8 = 16 * 128, I9 = 64 * 32;
        constexpr int NITEMS = I1 + 3 * I2 + I3 + I4 + I3 + I6 + I6 + I8 + I9;
        for (int it = gw; it < NITEMS; it += NGW) {
            int r = it;
            if (r < I1) { transpose_item8(w_in, NIN, 0, 112, Wqkv8, norm1_g, 1, 128.0f, scr, r, lane); continue; } r -= I1;
            if (r < 3 * I2) { const int br = r / I2; transpose_item8(w_in, NIN, NQKV + 1024 * br, 32, (unsigned char*)W3, norm1_g, 0, 32.0f, scr, r - br * I2, lane, 4352, 1024 * br); continue; } r -= 3 * I2;
            if (r < I3) { transpose_item8(w_br_a, 1024, 0, 32, (unsigned char*)W3, nullptr, 0, 32.0f, scr, r, lane, 4352, 3072); continue; } r -= I3;
            if (r < I4) { transpose_item8(w_br_b, 1024, 0, 32, (unsigned char*)W3, nullptr, 0, 32.0f, scr, r, lane, 4352, 3072 + 512); continue; } r -= I4;
            if (r < I3) { transpose_item8(w_br_m, 1024, 0, 32, (unsigned char*)W3, nullptr, 0, 32.0f, scr, r, lane, 4352, 3072 + 768); continue; } r -= I3;
            if (r < I6) { transpose_item(w_mem_kv, 1024, 0, 32, Wmem, 1024, 0, mem_norm_g, 0, scr, r, lane); continue; } r -= I6;
            if (r < I6) { transpose_item8(w_out, 1024, 0, 32, (unsigned char*)Wout, nullptr, 0, 32.0f, scr, r, lane); continue; } r -= I6;
            if (r < I8) { transpose_item(w_up, DFF, 0, 128, Wup, 1024, 0, norm2_g, 0, scr, r, lane); continue; } r -= I8;
            transpose_item(w_down, 1024, 0, 32, Wdn, DFF, 0, nullptr, 0, scr, r, lane);
        }
        for (int row = gw; row < TT; row += 4 * NGW) {
            const float* xr[4]; bf16_t* orw[4]; unsigned char* o8[4];
#pragma unroll
            for (int r = 0; r < 4; ++r) { int rw = row + r * NGW; rw = rw < TT ? rw : row; xr[r] = rw < TP ? x_p + (size_t)rw * DM : x_s + (size_t)(rw - TP) * DM; orw[r] = nullptr; o8[r] = (unsigned char*)hcat + (size_t)rw * (LDH * 2); }
            rms_rows_to_bf16<4>(xr, orw, o8, lane);
        }
        for (int row = gw; row < TMEM; row += NGW) {
            const float* xr[1] = {row < 32 * NMEM ? mem_p + (size_t)row * DM : mem_s + (size_t)(row - 32 * NMEM) * DM}; bf16_t* orw[1] = {memn + (size_t)row * DM}; unsigned char* o8[1] = {nullptr};
            rms_rows_to_bf16<1>(xr, orw, o8, lane);
        }
        const int gt = bx * 512 + tid;
        if (gt < 8 * NBA) { const int hd = gt / NBA, o = gt - hd * NBA - 32; biasA[gt] = (o >= 0 && o <= 256) ? rel_bias[t5_bucket(o - 128) * 20 + hd] * 1.4426950408889634f : -1e30f; }
        else if (gt < 8 * NBA + 12 * NBB) { const int e = gt - 8 * NBA, hd = e / NBB, o = e - hd * NBB - 32, gi = hd >> 2; const int dil = gi == 0 ? 1 : (gi == 1 ? 4 : 16);
            biasB[e] = (o >= 0 && o <= 128) ? rel_bias[t5_bucket(dil * (o - 64)) * 20 + 8 + hd] * 1.4426950408889634f : -1e30f; }
    }
    if (args.out == nullptr) grid.sync();
    xcd_barrier(xbar, wave);

    for (int rep_ = 0; rep_ < 1 + ((REPMASK >> 1) & 1); ++rep_) {
        int nt8 = 8; asm volatile("" : "+s"(nt8));
        { pg8::Gemm g{hcat, (const bf16_t*)Wqkv8, LDH, 512}; pg8::SchedQkv S{bx, nt8}; pg8::EpiStoreBf16 E{qkv, NQKV, 1.0f / 128.0f};
          pg8::gemm_phase<pg8::EpiStoreBf16, pg8::SchedQkv, true, true, true>(lds, g, S, E, wave); }
        { pg8::Gemm g{memn, Wmem, 1024, 1024}; pg8::Sched<1> S{TMEM / 256, 4, G, bx >= 96 ? bx - 96 : (1 << 20), 16}; pg8::EpiStoreBf16 E{mkv, 1024, 1.0f};
          pg8::gemm_phase<pg8::EpiStoreBf16, pg8::Sched<1>, true, true>(lds, g, S, E, wave); }
    }
    xcd_barrier(xbar, wave);

    for (int rep_ = 0; rep_ < 1 + ((REPMASK >> 2) & 1); ++rep_) {
        constexpr int NU_M = NB * 4 * 2, NU_A = NB * 2 * 8, NU_B = 3 * NB * 4 * 8, NU = NU_M + NU_A + NU_B;
        auto decode = [&](int u) -> UDesc {
            UDesc d;
            if (u < NU_M) {
                const int b = u >> 3, hm = (u >> 1) & 3, qc = u & 1; const size_t tok0 = (size_t)b * SEQ + qc * 1024;
                d.type = 0; d.kp = mkv + (size_t)b * NMEM * 1024 + hm * 128; d.vp = d.kp + 512; d.qp = qkv + tok0 * NQKV + 3072 + hm * 128; d.op = (bf16_t*)((unsigned char*)hcat + tok0 * (LDH * 2) + 2048 + 768 + hm * 128);
                d.tstride = NQKV; d.sstride = 0; d.nh = 1; d.Ld = 256; d.q0 = 0; d.QB = 1024; d.HALF = 0; d.nsub = 1; d.bias = biasA; d.sink = nullptr;
                d.o_tstride = LDH; d.o_sstride = 0; d.lsep = nullptr; d.l_tstride = 0; d.l_sstride = 0;
            } else if (u < NU_M + NU_A) {
                const int e = u - NU_M, b = e >> 4, kvh = (e >> 3) & 1, qb = e & 7;
                const bf16_t* base = qkv + (size_t)b * SEQ * NQKV;
                d.type = 1; d.qp = base + kvh * 256; d.kp = base + 512 + kvh * 64; d.vp = base + 640 + kvh * 64; d.tstride = NQKV; d.sstride = 0;
                d.nh = 4; d.Ld = SEQ; d.q0 = qb * 256; d.QB = 256; d.HALF = 128; d.nsub = 1;
                d.bias = biasA + kvh * 4 * NBA; d.sink = sink_logit + kvh * 4;
                d.op = (bf16_t*)((unsigned char*)hcat + (size_t)b * SEQ * (LDH * 2) + 2048 + kvh * 256); d.o_tstride = LDH * 2; d.o_sstride = 0; d.lsep = nullptr; d.l_tstride = 0; d.l_sstride = 0;
            } else {
                const int e = u - NU_M - NU_A, gi = e / (NB * 32), e2 = e - gi * (NB * 32), b = e2 >> 5, j = (e2 >> 3) & 3, blk = e2 & 7;
                const int hB = 4 * gi + j;
                int r, q0, dil;
                if (gi == 0) { dil = 1; r = 0; q0 = blk * 256; d.QB = 256; d.nsub = 1; d.Ld = 2048; }
                else if (gi == 1) { dil = 4; r = blk >> 1; q0 = (blk & 1) * 256; d.QB = 256; d.nsub = 1; d.Ld = 512; }
                else { dil = 16; r = blk * 2; q0 = 0; d.QB = 128; d.nsub = 2; d.Ld = 128; }
                const size_t tok0 = (size_t)b * SEQ + r;
                const bf16_t* base = qkv + tok0 * NQKV;
                d.type = 1; d.qp = base + 768 + hB * 64; d.kp = base + 1536 + hB * 64; d.vp = base + 2304 + hB * 64; d.tstride = (long)dil * NQKV; d.sstride = NQKV;
                d.nh = 1; d.q0 = q0; d.HALF = 64;
                d.bias = biasB + hB * NBB; d.sink = nullptr;
                d.op = og + ((size_t)gi * TT + tok0) * 256 + j * 64; d.o_tstride = (long)dil * 256; d.o_sstride = 256;
                d.lsep = lse + ((size_t)gi * TT + tok0) * 4 + j; d.l_tstride = (long)dil * 4; d.l_sstride = 4;
            }
            return d;
        };
        int u = bx;
        for (; u < NU_M; u += G) {
            const UDesc cur = decode(u);
            u32x4 kr[8], vr[8]; float bv[3]; stage_issue(cur, wave, kr, vr, bv);
            bf16x8 qf[8]; { const int lane = lane_id(); const bf16_t* qrow = cur.qp + (size_t)(wave * 32 + (lane & 31)) * NQKV + 8 * (lane >> 5);
#pragma unroll
              for (int d0 = 0; d0 < 8; ++d0) qf[d0] = *(const bf16x8*)(qrow + 16 * d0); }
            stage_commit(cur, (LAS char*)lds, wave, kr, vr, bv); __syncthreads();
            mem_compute((LAS char*)lds, cur, wave, qf);
        }
        for (; u < NU_M + NU_A; u += G) {
            const UDesc cur = decode(u);
            u32x4 kr[8], vr[8]; float bv[3]; stage_issue(cur, wave, kr, vr, bv);
            bf16x8 qf[4]; { const int lane = lane_id(); const bf16_t* qrow = band_qrow(cur, wave, lane & 31, lane >> 5);
#pragma unroll
              for (int d0 = 0; d0 < 4; ++d0) qf[d0] = *(const bf16x8*)(qrow + 16 * d0); }
            stage_commit(cur, (LAS char*)lds, wave, kr, vr, bv); __syncthreads();
            band_compute<9, true>((LAS char*)lds, cur, wave, qf);
        }
        {
            unsigned* qctr = (unsigned*)(ws + 28672);
            volatile LAS int* qw = (volatile LAS int*)(lds + 138256);
            const bool t0 = (wave == 0) && (lane_id() == 0);
            if (t0) qw[0] = (int)__hip_atomic_fetch_add(qctr, 1u, __ATOMIC_RELAXED, __HIP_MEMORY_SCOPE_AGENT);
            __syncthreads();
            int ub = qw[0], itq = 0;
            while (ub < NU_B) {
                unsigned nx = 0u; if (t0) nx = __hip_atomic_fetch_add(qctr, 1u, __ATOMIC_RELAXED, __HIP_MEMORY_SCOPE_AGENT);
                const UDesc cur = decode(NU_M + NU_A + ub);
                u32x4 kr[8], vr[8]; float bv[3]; stage_issue(cur, wave, kr, vr, bv);
                bf16x8 qf[4]; { const int lane = lane_id(); const bf16_t* qrow = band_qrow(cur, wave, lane & 31, lane >> 5);
#pragma unroll
                  for (int d0 = 0; d0 < 4; ++d0) qf[d0] = *(const bf16x8*)(qrow + 16 * d0); }
                stage_commit(cur, (LAS char*)lds, wave, kr, vr, bv); __syncthreads();
                band_compute<5, false>((LAS char*)lds, cur, wave, qf);
                itq ^= 1;
                if (t0) qw[itq] = (int)nx;
                __syncthreads();
                ub = qw[itq];
            }
        }
    }
    xcd_barrier(xbar, wave);

    for (int rep_ = 0; rep_ < 1 + ((REPMASK >> 3) & 1); ++rep_) {
        const int tid = wave * 64 + lane_id();
        const size_t nitems = (size_t)TT * 32;
        for (size_t it = (size_t)bx * 512 + tid; it < nitems; it += (size_t)G * 512) {
            const size_t tok = it >> 5; const int j = (int)(it >> 3) & 3, c = (int)it & 7;
            const float l0 = lse[tok * 4 + j], l1 = lse[((size_t)TT + tok) * 4 + j], l2 = lse[((size_t)2 * TT + tok) * 4 + j];
            const float mx = fmaxf(l0, fmaxf(l1, l2)); float w0 = __builtin_amdgcn_exp2f(l0 - mx), w1 = __builtin_amdgcn_exp2f(l1 - mx), w2 = __builtin_amdgcn_exp2f(l2 - mx); const float inv = 1.0f / (w0 + w1 + w2);
            w0 *= inv; w1 *= inv; w2 *= inv;
            const u32x4 a = *(const u32x4*)(og + tok * 256 + j * 64 + c * 8), bq = *(const u32x4*)(og + ((size_t)TT + tok) * 256 + j * 64 + c * 8), cq = *(const u32x4*)(og + ((size_t)2 * TT + tok) * 256 + j * 64 + c * 8);
            float f[8];
#pragma unroll
            for (int e = 0; e < 4; ++e) { f[2 * e] = w0 * bf2f((unsigned short)(a[e] & 0xffff)) + w1 * bf2f((unsigned short)(bq[e] & 0xffff)) + w2 * bf2f((unsigned short)(cq[e] & 0xffff));
                f[2 * e + 1] = w0 * bf2f((unsigned short)(a[e] >> 16)) + w1 * bf2f((unsigned short)(bq[e] >> 16)) + w2 * bf2f((unsigned short)(cq[e] >> 16)); }
            u32x2 o; o.x = pk_fp8x4(f[0] * 16.f, f[1] * 16.f, f[2] * 16.f, f[3] * 16.f); o.y = pk_fp8x4(f[4] * 16.f, f[5] * 16.f, f[6] * 16.f, f[7] * 16.f);
            *(u32x2*)((unsigned char*)hcat + tok * (LDH * 2) + 2048 + 512 + j * 64 + c * 8) = o;
        }
    }
    xcd_barrier(xbar, wave);

    for (int rep_ = 0; rep_ < 1 + ((REPMASK >> 4) & 1); ++rep_) {
        u32x2* tbase = (u32x2*)out + (size_t)bx * (2 * 32 * 512);
        pg8::Gemm g{hcat, W3, LDH, 2176}; pg8::Sched<6> S{TT / 256, 4, G, bx, 0}; pg8::EpiGate6 E{tbase, merged};
        pg8::gemm_phase<pg8::EpiGate6, pg8::Sched<6>, true, true, true>(lds, g, S, E, wave);
    }
    xcd_barrier(xbar, wave);

    for (int rep_ = 0; rep_ < 1 + ((REPMASK >> 5) & 1); ++rep_) {
        int nt8 = 8; asm volatile("" : "+s"(nt8));
        pg8::Gemm g{merged, Wout, 512, 512}; pg8::Sched<1> S{TT / 256, 4, G, bx, nt8}; pg8::EpiOut E{x_p, x_s, out, x1b, ssq, 1.0f / 512.0f};
        pg8::gemm_phase<pg8::EpiOut, pg8::Sched<1>, true, true, true>(lds, g, S, E, wave);
    }
    xcd_barrier(xbar, wave);

    for (int rep_ = 0; rep_ < 1 + ((REPMASK >> 6) & 1); ++rep_) {
        pg8::Gemm g{x1b, Wup, 1024, 1024}; pg8::Sched<1> S{TT / 256, 16, G, bx, 16}; pg8::EpiUp E{hid, ssq};
        pg8::gemm_phase<pg8::EpiUp, pg8::Sched<1>, false, true>(lds, g, S, E, wave);
    }
    xcd_barrier(xbar, wave);

    for (int rep_ = 0; rep_ < 1; ++rep_) {
        pg8::Gemm g{hid, Wdn, DFF, DFF}; pg8::Sched<1> S{TT / 256, 4, G, bx, 64}; pg8::EpiDownNorm E{out, x1b, ssq, (unsigned*)(ws + 4096), final_g};
        pg8::gemm_phase<pg8::EpiDownNorm, pg8::Sched<1>, true, true>(lds, g, S, E, wave);
    }
}

extern "C" void kernel_launch(void* const* d_in, const int* in_sizes, int n_in, void* d_out, int out_size, void* d_ws, size_t ws_size, hipStream_t stream) {
    static int grid = 0;
    if (grid == 0) {
        if (n_in != 18 || out_size != TT * DM || ws_size < WS_END) { fprintf(stderr, "kernel_launch: unexpected shapes (n_in %d out %d ws %zu)\n", n_in, out_size, ws_size); grid = -1; return; }
        int dev = 0, cus = 0, per_cu = 0;
        hipGetDevice(&dev);
        hipDeviceGetAttribute(&cus, hipDeviceAttributeMultiprocessorCount, dev);
        hipFuncSetAttribute((const void*)fwd_megakernel, hipFuncAttributeMaxDynamicSharedMemorySize, LDS_BYTES);
        hipOccupancyMaxActiveBlocksPerMultiprocessor(&per_cu, (const void*)fwd_megakernel, 512, LDS_BYTES);
        if (per_cu < 1) { fprintf(stderr, "kernel_launch: occupancy query says %d blocks per CU\n", per_cu); per_cu = 1; }
        grid = cus * per_cu;
        if (grid < 256) { fprintf(stderr, "kernel_launch: needs 256 co-resident workgroups, device offers %d\n", grid); grid = -1; return; }
        grid = 256;
    }
    if (grid < 0) return;
    hipMemsetAsync(d_ws, 0, 65536, stream);
    Args a{};
    for (int i = 0; i < 18; ++i) a.in[i] = (const float*)d_in[i];
    a.out = (float*)d_out; a.ws = (unsigned char*)d_ws;
    void* kargs[] = {&a};
    hipError_t e = hipLaunchCooperativeKernel((const void*)fwd_megakernel, dim3(grid), dim3(512), kargs, LDS_BYTES, stream);
    if (e != hipSuccess) fprintf(stderr, "cooperative launch failed: %s (grid %d)\n", hipGetErrorString(e), grid);
}
```

```cpp
#include <hip/hip_runtime.h>
#include <hip/hip_cooperative_groups.h>
#include <cstdio>
#include <cstdint>
namespace cg = cooperative_groups;

#define LAS __attribute__((address_space(3)))
typedef unsigned short bf16_t;
typedef short bf16x8 __attribute__((ext_vector_type(8)));
typedef short s16x4 __attribute__((ext_vector_type(4)));
typedef short v4i16_t __attribute__((ext_vector_type(4)));
typedef float f32x4 __attribute__((ext_vector_type(4)));
typedef float f32x16 __attribute__((ext_vector_type(16)));
typedef unsigned u32x4 __attribute__((ext_vector_type(4)));
typedef unsigned u32x2 __attribute__((ext_vector_type(2)));
typedef int v8i_t __attribute__((ext_vector_type(8)));

constexpr int DM = 1024, TP = 32 * 2048, TS = 8 * 2048, TT = TP + TS;
constexpr int NB = 40, SEQ = 2048, NMEM = 256, TMEM = NB * NMEM;
constexpr int NQKV = 3584, NIN = 6656, LDH = 2304, LDW3 = 4352, DFF = 4096;
constexpr int HC_OA = 1024, HC_OB = 1536, HC_OM = 1792;
constexpr float EPS = 1e-6f;
constexpr size_t MiB = 1u << 20;
constexpr int NBA = 320, NBB = 192;
constexpr size_t WS_BIASA = 1 * MiB, WS_BIASB = WS_BIASA + 8 * NBA * 4;
constexpr size_t WS_WQKV = 2 * MiB, WS_W3 = 9 * MiB, WS_WMEM = 18 * MiB, WS_WOUT = 20 * MiB, WS_WUP = 22 * MiB, WS_WDN = 30 * MiB;
constexpr size_t WS_MEMN = 38 * MiB, WS_MKV = 58 * MiB, WS_SSQ = 78 * MiB, WS_LSE = 83 * MiB;
constexpr size_t WS_QKV = 88 * MiB, WS_HCAT = 648 * MiB, WS_END = 1008 * MiB;
constexpr size_t WS_X1B = 88 * MiB, WS_MERGED = 248 * MiB, WS_HID = 248 * MiB;
constexpr size_t DO_OG = 0;
constexpr int LDS_BYTES = 163840;

__device__ __forceinline__ int lane_id() { int l; asm volatile("v_mbcnt_lo_u32_b32 %0, -1, 0\n\tv_mbcnt_hi_u32_b32 %0, -1, %0" : "=v"(l)); return l; }
__device__ __forceinline__ unsigned f2bf(float f) { unsigned u = __builtin_bit_cast(unsigned, f); return (u + 0x7fffu + ((u >> 16) & 1u)) >> 16; }
typedef float f32x2_t __attribute__((ext_vector_type(2))); typedef __bf16 bf16x2_t __attribute__((ext_vector_type(2)));
__device__ __forceinline__ unsigned pk2(float lo, float hi) { f32x2_t v = {lo, hi}; bf16x2_t b = __builtin_convertvector(v, bf16x2_t); return __builtin_bit_cast(unsigned, b); }
__device__ __forceinline__ unsigned pk_fp8x4(float a, float b, float c, float d) { int w = 0; w = __builtin_amdgcn_cvt_pk_fp8_f32(a, b, w, false); w = __builtin_amdgcn_cvt_pk_fp8_f32(c, d, w, true); return (unsigned)w; }
__device__ __forceinline__ float bf2f(unsigned short b) { return __builtin_bit_cast(float, (unsigned)b << 16); }
__device__ __forceinline__ float wave_sum(float v) {
#pragma unroll
    for (int o = 1; o < 64; o <<= 1) v += __shfl_xor(v, o);
    return v;
}
__device__ __forceinline__ int t5_bucket(int rel) {
    int n = rel < 0 ? -rel : rel;
    int b = n < 8 ? n : 8 + (n >= 15) + (n >= 27) + (n >= 50) + (n >= 91) + (n >= 166) + (n >= 305) + (n >= 559);
    return b + (rel > 0 ? 16 : 0);
}

namespace pg8 {
constexpr int BM = 256, BK = 64, HALF = 128, HTB = HALF * BK * 2, STAGE_BYTES = 8 * HTB, NXCD = 8, WGM = 8;
__device__ __forceinline__ int lds_byte(int r, int c) { const int st = (r >> 4) * 2 + (c >> 5), rr = r & 15, cc = c & 31, ob = rr * 64 + cc * 2; return st * 1024 + (ob ^ (((ob >> 9) & 1) << 5)); }
__device__ __forceinline__ void stage_rc(int b, int& R, int& C) { const int st = b / 1024, sb = b % 1024, swz = sb ^ (((sb >> 9) & 1) << 5); R = (st >> 1) * 16 + swz / 64; C = (st & 1) * 32 + (swz % 64) / 2; }
__device__ __forceinline__ int perm32(int rho) { const int n = rho >> 4, i = rho & 15; return 8 * (i >> 2) + 4 * n + (i & 3); }

struct Unit { int pm, pn, aoff, boff, nt, mode; };
struct Gemm { const bf16_t* A; const bf16_t* Bt; int lda, ldb; };

__device__ __forceinline__ void tile_of(int L, int nM, int nN, int& pm, int& pn) {
    const int nwg = nM * nN; int wgid = L;
    { const int q = nwg / NXCD, r = nwg % NXCD, xcd = wgid % NXCD, off = wgid / NXCD; wgid = (xcd < r ? xcd * (q + 1) : r * (q + 1) + (xcd - r) * q) + off; }
    const int nig = WGM * nN, gid = wgid / nig, fm = gid * WGM, gsz = (nM - fm) < WGM ? (nM - fm) : WGM;
    pm = fm + ((wgid % nig) % gsz); pn = (wgid % nig) / gsz;
}
template <int NSUB> struct Sched {
    int nM, nN, G, c, nt0;
    __device__ __forceinline__ bool next(int i, Unit& u) const {
        const int ti = (NSUB == 1) ? i : i / NSUB, sub = (NSUB == 1) ? 0 : i - ti * NSUB;
        const long L = (long)ti * G + c; if (L >= (long)nM * nN) return false;
        tile_of((int)L, nM, nN, u.pm, u.pn);
        if (NSUB == 1) { u.aoff = 0; u.boff = 0; u.nt = nt0; u.mode = 0; }
        else {
            const int br = sub >> 1;
            if ((sub & 1) == 0) { u.aoff = 0; u.boff = 512 * br; u.nt = 8; u.mode = 0; }
            else { u.aoff = br == 0 ? 1024 : (br == 1 ? 1280 : 1408); u.boff = 1536 + (br == 0 ? 0 : (br == 1 ? 256 : 384)); u.nt = br == 1 ? 2 : 4; u.mode = br + 1; }
        }
        asm volatile("" : "+s"(u.nt));
        return true;
    }
};

struct SchedQkv {
    int c, nt0;
    __device__ __forceinline__ bool next(int i, Unit& u) const {
        int L;
        if (i < 17) L = i * 256 + c;
        else if (c < 96 && i == 17) L = 17 * 256 + c;
        else if (c < 32 && i == 18) L = 17 * 256 + 96 + c;
        else return false;
        tile_of(L, TT / 256, NQKV / 256, u.pm, u.pn);
        u.aoff = 0; u.boff = 0; u.nt = nt0; u.mode = 0;
        return true;
    }
};

struct EpiStoreBf16 {
    static constexpr bool PERM = true;
    bf16_t* O; int ldc; float sc;
    __device__ __forceinline__ void operator()(const f32x4 (&acc)[2][2][4][2], const Unit& u, int wr, int wc, int fr, int fq) const {
        asm volatile("" : "+v"(fr), "+v"(fq));
        const int row0 = u.pm * BM + wr * 64 + fr, col0 = u.pn * BM + wc * 32 + 8 * fq;
#pragma unroll
        for (int ai = 0; ai < 2; ++ai)
#pragma unroll
            for (int m = 0; m < 4; ++m) { bf16_t* rowp = O + (size_t)(row0 + ai * HALF + m * 16) * ldc + col0;
#pragma unroll
                for (int bj = 0; bj < 2; ++bj) { const f32x4 v0 = acc[ai][bj][m][0] * sc, v1 = acc[ai][bj][m][1] * sc;
                    u32x4 w; w.x = pk2(v0[0], v0[1]); w.y = pk2(v0[2], v0[3]); w.z = pk2(v1[0], v1[1]); w.w = pk2(v1[2], v1[3]);
                    *(u32x4*)(rowp + bj * HALF) = w; } }
    }
};
struct EpiUp {
    static constexpr bool PERM = true;
    bf16_t* O; const float* ssq;
    __device__ __forceinline__ void operator()(const f32x4 (&acc)[2][2][4][2], const Unit& u, int wr, int wc, int fr, int fq) const {
        const int row0 = u.pm * BM + wr * 64 + fr, col0 = u.pn * BM + wc * 32 + 8 * fq;
        f32x4 sp[2][4];
#pragma unroll
        for (int ai = 0; ai < 2; ++ai)
#pragma unroll
            for (int m = 0; m < 4; ++m) sp[ai][m] = *(const f32x4*)(ssq + (size_t)(row0 + ai * HALF + m * 16) * 16 + 4 * fq);
#pragma unroll
        for (int ai = 0; ai < 2; ++ai)
#pragma unroll
            for (int m = 0; m < 4; ++m) { const int row = row0 + ai * HALF + m * 16;
                float t = (sp[ai][m][0] + sp[ai][m][1]) + (sp[ai][m][2] + sp[ai][m][3]); t += __shfl_xor(t, 16); t += __shfl_xor(t, 32);
                const float rs = rsqrtf(t * (1.0f / DM) + EPS);
                bf16_t* rowp = O + (size_t)row * DFF + col0;
#pragma unroll
                for (int bj = 0; bj < 2; ++bj) { f32x4 v0 = acc[ai][bj][m][0] * rs, v1 = acc[ai][bj][m][1] * rs;
#pragma unroll
                    for (int e = 0; e < 4; ++e) { v0[e] = fmaxf(v0[e], 0.f); v0[e] *= v0[e]; v1[e] = fmaxf(v1[e], 0.f); v1[e] *= v1[e]; }
                    u32x4 w; w.x = pk2(v0[0], v0[1]); w.y = pk2(v0[2], v0[3]); w.z = pk2(v1[0], v1[1]); w.w = pk2(v1[2], v1[3]);
                    *(u32x4*)(rowp + bj * HALF) = w; } }
    }
};
__device__ __forceinline__ f32x4 unpk4(u32x2 w) { f32x4 r; r[0] = __builtin_bit_cast(float, w.x << 16); r[1] = __builtin_bit_cast(float, w.x & 0xffff0000u); r[2] = __builtin_bit_cast(float, w.y << 16); r[3] = __builtin_bit_cast(float, w.y & 0xffff0000u); return r; }
__device__ __forceinline__ u32x2 pk4(f32x4 v) { u32x2 w; w.x = pk2(v[0], v[1]); w.y = pk2(v[2], v[3]); return w; }
struct EpiGate {
    static constexpr bool PERM = true;
    u32x2* tg_; u32x2* tm_; bf16_t* O;
    __device__ __forceinline__ void operator()(const f32x4 (&acc)[2][2][4][2], const Unit& u, int wr, int wc, int fr, int fq) const {
        const int mode = u.mode;
        u32x2* tg = tg_; u32x2* tm = tm_;
        asm volatile("" : "+v"(tg), "+v"(tm));
        if (mode == 0) {
#pragma unroll
            for (int ai = 0; ai < 2; ++ai)
#pragma unroll
                for (int bj = 0; bj < 2; ++bj)
#pragma unroll
                    for (int m = 0; m < 4; ++m)
#pragma unroll
                        for (int n = 0; n < 2; ++n) { const int idx = ((ai * 2 + bj) * 4 + m) * 2 + n; f32x4 a = acc[ai][bj][m][n], s;
#pragma unroll
                            for (int e = 0; e < 4; ++e) s[e] = __builtin_amdgcn_rcpf(1.0f + __builtin_amdgcn_exp2f(-1.4426950408889634f * a[e]));
                            tg[idx * 64] = pk4(s); if (n) asm volatile("" ::: "memory"); }
        } else {
            const int row0 = u.pm * BM + wr * 64 + fr, col0 = u.pn * BM + wc * 32 + 8 * fq;
#pragma unroll
            for (int ai = 0; ai < 2; ++ai) {
                u32x2 g[16], t[16];
#pragma unroll
                for (int k = 0; k < 16; ++k) { g[k] = tg[(ai * 16 + k) * 64]; if (mode != 1) t[k] = tm[(ai * 16 + k) * 64]; }
#pragma unroll
                for (int bj = 0; bj < 2; ++bj)
#pragma unroll
                    for (int m = 0; m < 4; ++m) { const int k = (bj * 4 + m) * 2;
                        f32x4 v0 = unpk4(g[k]) * acc[ai][bj][m][0], v1 = unpk4(g[k + 1]) * acc[ai][bj][m][1];
                        if (mode != 1) { v0 += unpk4(t[k]); v1 += unpk4(t[k + 1]); }
                        if (mode != 3) { tm[(ai * 16 + k) * 64] = pk4(v0); tm[(ai * 16 + k + 1) * 64] = pk4(v1); }
                        else { u32x4 w; w.x = pk2(v0[0], v0[1]); w.y = pk2(v0[2], v0[3]); w.z = pk2(v1[0], v1[1]); w.w = pk2(v1[2], v1[3]);
                               *(u32x4*)(O + (size_t)(row0 + ai * HALF + m * 16) * DM + col0 + bj * HALF) = w; } }
                asm volatile("" ::: "memory");
            }
        }
    }
};
template <bool GATE> struct SchedFix {
    int pm, pn;
    __device__ __forceinline__ bool next(int i, Unit& u) const {
        int lim = 3; asm volatile("" : "+s"(lim));
        asm volatile("" : "+s"(i));
        if (i >= lim) return false;
        u.pm = pm; u.pn = pn; u.mode = i;
        if (GATE) { u.aoff = 0; u.boff = i * 524288; u.nt = 8; }
        else { u.aoff = i == 0 ? 1024 : (i == 1 ? 1280 : 1408); u.boff = i == 0 ? 0 : (i == 1 ? 256 : 384); u.nt = i == 1 ? 2 : 4; }
        asm volatile("" : "+s"(u.nt));
        return true;
    }
};
struct EpiGate6 {
    static constexpr bool PERM = true;
    u32x2* tb_; bf16_t* O;
    __device__ __forceinline__ void operator()(const f32x4 (&acc)[2][2][4][2], const Unit& u, int wr, int wc, int fr, int fq) const {
        const int mode = u.mode;
        const int loff = (wr * 4 + wc) * (32 * 64) + fq * 16 + fr;
        u32x2* tg = tb_ + loff; u32x2* tm = tb_ + 32 * 512 + loff;
        asm volatile("" : "+v"(tg), "+v"(tm));
        if (mode == 0) {
#pragma unroll
            for (int ai = 0; ai < 2; ++ai)
#pragma unroll
                for (int bj = 0; bj < 2; ++bj)
#pragma unroll
                    for (int m = 0; m < 4; ++m)
#pragma unroll
                        for (int n = 0; n < 2; ++n) { const int idx = ((ai * 2 + bj) * 4 + m) * 2 + n; f32x4 a = acc[ai][bj][m][n], sg;
#pragma unroll
                            for (int e = 0; e < 4; ++e) sg[e] = __builtin_amdgcn_rcpf(1.0f + __builtin_amdgcn_exp2f((-1.4426950408889634f / 32.0f) * a[e]));
                            tg[idx * 64] = pk4(sg); if (n) asm volatile("" ::: "memory"); }
        } else {
            const int row0 = u.pm * BM + wr * 64 + fr, col0 = u.pn * BM + wc * 32 + 8 * fq;
#pragma unroll
            for (int ai = 0; ai < 2; ++ai) {
                u32x2 g[16], t[16];
#pragma unroll
                for (int k = 0; k < 16; ++k) { g[k] = tg[(ai * 16 + k) * 64]; if (mode != 1) t[k] = tm[(ai * 16 + k) * 64]; }
#pragma unroll
                for (int bj = 0; bj < 2; ++bj)
#pragma unroll
                    for (int m = 0; m < 4; ++m) { const int k = (bj * 4 + m) * 2;
                        f32x4 v0 = unpk4(g[k]) * (acc[ai][bj][m][0] * (1.0f / 512.0f)), v1 = unpk4(g[k + 1]) * (acc[ai][bj][m][1] * (1.0f / 512.0f));
                        if (mode != 1) { v0 += unpk4(t[k]); v1 += unpk4(t[k + 1]); }
                        if (mode != 3) { tm[(ai * 16 + k) * 64] = pk4(v0); tm[(ai * 16 + k + 1) * 64] = pk4(v1); }
                        else { u32x2 w; w.x = pk_fp8x4(v0[0] * 16.f, v0[1] * 16.f, v0[2] * 16.f, v0[3] * 16.f); w.y = pk_fp8x4(v1[0] * 16.f, v1[1] * 16.f, v1[2] * 16.f, v1[3] * 16.f);
                               *(u32x2*)((unsigned char*)O + (size_t)(row0 + ai * HALF + m * 16) * DM + col0 + bj * HALF) = w; } }
                asm volatile("" ::: "memory");
            }
        }
    }
};
struct EpiOut {
    static constexpr bool PERM = false;
    const float* xp; const float* xs; float* out; bf16_t* x1b; float* ssq; float sc;
    __device__ __forceinline__ void operator()(const f32x4 (&acc)[2][2][4][2], const Unit& u, int wr, int wc, int fr, int fq) const {
        const int row0 = u.pm * BM + wr * 64 + fr, col0 = u.pn * BM + wc * 32 + 4 * fq;
#pragma unroll
        for (int ai = 0; ai < 2; ++ai)
#pragma unroll
            for (int m = 0; m < 4; ++m) { const int row = row0 + ai * HALF + m * 16;
                const float* xr = (row < TP ? xp + (size_t)row * DM : xs + (size_t)(row - TP) * DM) + col0;
                bf16_t* brow = x1b + (size_t)row * DM + col0; float ss = 0.f;
#pragma unroll
                for (int bj = 0; bj < 2; ++bj)
#pragma unroll
                    for (int n = 0; n < 2; ++n) { const int co = bj * HALF + n * 16; const f32x4 v = *(const f32x4*)(xr + co) + acc[ai][bj][m][n] * sc;
                        u32x2 w; w.x = pk2(v[0], v[1]); w.y = pk2(v[2], v[3]); *(u32x2*)(brow + co) = w;
                        ss += (v[0] * v[0] + v[1] * v[1]) + (v[2] * v[2] + v[3] * v[3]); }
                ss += __shfl_xor(ss, 16); ss += __shfl_xor(ss, 32);
                if (fq == 0) ssq[(size_t)row * 16 + u.pn * 4 + wc] = ss; }
    }
};
struct EpiDownNorm {
    static constexpr bool PERM = false;
    float* out; const bf16_t* x1b; float* xbuf; unsigned* cnt; const float* gf;
    __device__ __forceinline__ void operator()(f32x4 (&acc)[2][2][4][2], const Unit& u, int wr, int wc, int fr, int fq) const {
        const int row0 = u.pm * BM + wr * 64 + fr, col0 = u.pn * BM + wc * 32 + 4 * fq;
#pragma unroll
        for (int ai = 0; ai < 2; ++ai)
#pragma unroll
            for (int m = 0; m < 4; ++m) { const int row = row0 + ai * HALF + m * 16; const bf16_t* orow = x1b + (size_t)row * DM + col0; float ss = 0.f;
#pragma unroll
                for (int bj = 0; bj < 2; ++bj)
#pragma unroll
                    for (int n = 0; n < 2; ++n) { const f32x4 v = unpk4(*(const u32x2*)(orow + bj * HALF + n * 16)) + acc[ai][bj][m][n]; acc[ai][bj][m][n] = v;
                        ss += (v[0] * v[0] + v[1] * v[1]) + (v[2] * v[2] + v[3] * v[3]); }
                ss += __shfl_xor(ss, 16); ss += __shfl_xor(ss, 32);
                if (fq == 0) __hip_atomic_store(xbuf + (size_t)row * 16 + u.pn * 4 + wc, ss, __ATOMIC_RELAXED, __HIP_MEMORY_SCOPE_AGENT);
                if (m == 3) asm volatile("" ::: "memory"); }
        asm volatile("s_waitcnt vmcnt(0)" ::: "memory");
        unsigned* c = cnt + u.pm * 16;
        if (fr == 0 && fq == 0) __hip_atomic_fetch_add(c, 1u, __ATOMIC_RELAXED, __HIP_MEMORY_SCOPE_AGENT);
        while (__hip_atomic_load(c, __ATOMIC_RELAXED, __HIP_MEMORY_SCOPE_AGENT) < 32u) __builtin_amdgcn_s_sleep(1);
        asm volatile("" ::: "memory");
#pragma unroll
        for (int ai = 0; ai < 2; ++ai)
#pragma unroll
            for (int m = 0; m < 4; ++m) { const int row = row0 + ai * HALF + m * 16; float* orow = out + (size_t)row * DM + col0;
                const unsigned long long* sp = (const unsigned long long*)(xbuf + (size_t)row * 16 + 4 * fq);
                const unsigned long long qa = __hip_atomic_load(sp, __ATOMIC_RELAXED, __HIP_MEMORY_SCOPE_AGENT), qb = __hip_atomic_load(sp + 1, __ATOMIC_RELAXED, __HIP_MEMORY_SCOPE_AGENT);
                float t = (__uint_as_float((unsigned)qa) + __uint_as_float((unsigned)(qa >> 32))) + (__uint_as_float((unsigned)qb) + __uint_as_float((unsigned)(qb >> 32)));
                t += __shfl_xor(t, 16); t += __shfl_xor(t, 32);
                const float rs = rsqrtf(t * (1.0f / DM) + EPS);
#pragma unroll
                for (int bj = 0; bj < 2; ++bj)
#pragma unroll
                    for (int n = 0; n < 2; ++n) { const int co = bj * HALF + n * 16; const f32x4 g = *(const f32x4*)(gf + col0 + co); __builtin_nontemporal_store(acc[ai][bj][m][n] * rs * g, (f32x4*)(orow + co)); } }
    }
};

template <class Epi, class SchedT, bool ALIGN_EPI, bool SP2, bool FP8 = false>
__device__ __forceinline__ void gemm_phase(LAS unsigned char* lds, const Gemm g, const SchedT& S, const Epi& E, const int wid) {
    const int lane = lane_id(), tid = wid * 64 + lane, wr = wid >> 2, wc = wid & 3, fr = lane & 15, fq = lane >> 4;
    unsigned voffA[2], voffB[2];
#pragma unroll
    for (int i = 0; i < 2; ++i) { int R, C; stage_rc(tid * 16 + i * 8192, R, C); const int Rb = Epi::PERM ? ((R & ~31) + perm32(R & 31)) : R;
        voffA[i] = (unsigned)(R * g.lda + C) * 2u; voffB[i] = (unsigned)(Rb * g.ldb + C) * 2u; }
    const size_t kstep = (size_t)(BK * 2);
    const size_t hstepA = (size_t)HALF * g.lda * 2, hstepB = (size_t)HALF * g.ldb * 2;
    const size_t tstepA = 2 * hstepA, tstepB = 2 * hstepB;
    const unsigned ldsw = (unsigned)wid * 1024u;
    const int aoff = FP8 ? lds_byte(wr * 64 + fr, fq * 16) : lds_byte(wr * 64 + fr, fq * 8), boff = FP8 ? lds_byte(wc * 32 + fr, fq * 16) : lds_byte(wc * 32 + fr, fq * 8);
    const int aoff1 = FP8 ? lds_byte(wr * 64 + fr, fq * 16 + 8) : aoff + 1024, boff1 = FP8 ? lds_byte(wc * 32 + fr, fq * 16 + 8) : boff + 1024;
#define PG8_SA(b, h) (((b) * 2 + (h)) * HTB)
#define PG8_SB(b, h) ((4 + (b) * 2 + (h)) * HTB)
#define PG8_STAGE(bufoff, gbase, voff) do { _Pragma("unroll") for (int _i = 0; _i < 2; ++_i) { unsigned vo_ = (voff)[_i]; asm volatile("" : "+v"(vo_));     \
        __builtin_amdgcn_global_load_lds((const unsigned*)((const char*)(gbase) + vo_), (LAS unsigned*)(lds + (bufoff) + ldsw + _i * 8192), 16, 0, 0); } } while (0)
#define PG8_CAT(lo, hi) __builtin_bit_cast(v8i_t, __builtin_shufflevector(lo, hi, 0, 1, 2, 3, 4, 5, 6, 7, 8, 9, 10, 11, 12, 13, 14, 15))
#define PG8_LD8(base, off0, off1, g) PG8_CAT(*(const LAS bf16x8*)(lds + (base) + (off0) + (g) * 2048), *(const LAS bf16x8*)(lds + (base) + (off0) + 16 + (g) * 2048))
#define PG8_LDA(dst, b, h) do { if constexpr (FP8) { _Pragma("unroll") for (int m = 0; m < 4; ++m) dst##8[m] = PG8_LD8(PG8_SA(b, h), aoff, aoff1, m); } \
        else { _Pragma("unroll") for (int m = 0; m < 4; ++m) _Pragma("unroll") for (int k = 0; k < 2; ++k) dst[m][k] = *(const LAS bf16x8*)(lds + PG8_SA(b, h) + (k ? aoff1 : aoff) + m * 2048); } } while (0)
#define PG8_LDB(dst, b, h) do { if constexpr (FP8) { dst##8[0] = PG8_LD8(PG8_SB(b, h), boff, boff1, 0); dst##8[1] = PG8_LD8(PG8_SB(b, h), boff, boff1, 1); } \
        else { _Pragma("unroll") for (int n = 0; n < 2; ++n) _Pragma("unroll") for (int k = 0; k < 2; ++k) dst[n][k] = *(const LAS bf16x8*)(lds + PG8_SB(b, h) + (k ? boff1 : boff) + n * 2048); } } while (0)
#define PG8_F8(a_, b_, c_) __builtin_amdgcn_mfma_scale_f32_16x16x128_f8f6f4(a_, b_, c_, 0, 0, 0, 127, 0, 127)
#define PG8_MMA2(ai, b, h) do { __builtin_amdgcn_s_setprio(1); \
        _Pragma("unroll") for (int mm = 0; mm < 2; ++mm) _Pragma("unroll") for (int n = 0; n < 2; ++n) { acc[ai][0][mm][n] = PG8_F8(B08[n], At8[mm], acc[ai][0][mm][n]); acc[ai][1][mm][n] = PG8_F8(B18[n], At8[mm], acc[ai][1][mm][n]); } \
        At8[0] = PG8_LD8(PG8_SA(b, h), aoff, aoff1, 2); At8[1] = PG8_LD8(PG8_SA(b, h), aoff, aoff1, 3); PG8_WAIT_L(0); \
        _Pragma("unroll") for (int mm = 0; mm < 2; ++mm) _Pragma("unroll") for (int n = 0; n < 2; ++n) { acc[ai][0][2 + mm][n] = PG8_F8(B08[n], At8[mm], acc[ai][0][2 + mm][n]); acc[ai][1][2 + mm][n] = PG8_F8(B18[n], At8[mm], acc[ai][1][2 + mm][n]); } \
        PG8_WAIT_L(0); __builtin_amdgcn_s_setprio(0); } while (0)
#define PG8_MMA2S(ai, b, h, STG) do { __builtin_amdgcn_s_setprio(1); \
        _Pragma("unroll") for (int mm = 0; mm < 2; ++mm) _Pragma("unroll") for (int n = 0; n < 2; ++n) { acc[ai][0][mm][n] = PG8_F8(B08[n], At8[mm], acc[ai][0][mm][n]); acc[ai][1][mm][n] = PG8_F8(B18[n], At8[mm], acc[ai][1][mm][n]); } \
        At8[0] = PG8_LD8(PG8_SA(b, h), aoff, aoff1, 2); At8[1] = PG8_LD8(PG8_SA(b, h), aoff, aoff1, 3); PG8_WAIT_L(0); PG8_SCHED; STG; \
        _Pragma("unroll") for (int mm = 0; mm < 2; ++mm) _Pragma("unroll") for (int n = 0; n < 2; ++n) { acc[ai][0][2 + mm][n] = PG8_F8(B08[n], At8[mm], acc[ai][0][2 + mm][n]); acc[ai][1][2 + mm][n] = PG8_F8(B18[n], At8[mm], acc[ai][1][2 + mm][n]); } \
        __builtin_amdgcn_s_setprio(0); } while (0)
#define PG8_MMA(ai, bj, At, Bt) do { __builtin_amdgcn_s_setprio(1); _Pragma("unroll") for (int m = 0; m < 4; ++m) _Pragma("unroll") for (int n = 0; n < 2; ++n) _Pragma("unroll") for (int k = 0; k < 2; ++k) \
        acc[ai][bj][m][n] = __builtin_amdgcn_mfma_f32_16x16x32_bf16(Bt[n][k], At[m][k], acc[ai][bj][m][n], 0, 0, 0); __builtin_amdgcn_s_setprio(0); } while (0)
#define PG8_MMAP(ai, b, h) do { if constexpr (FP8) { __builtin_amdgcn_s_setprio(1); \
        _Pragma("unroll") for (int m = 0; m < 4; ++m) _Pragma("unroll") for (int n = 0; n < 2; ++n) { acc[ai][0][m][n] = PG8_F8(B08[n], At8[m], acc[ai][0][m][n]); acc[ai][1][m][n] = PG8_F8(B18[n], At8[m], acc[ai][1][m][n]); } \
        __builtin_amdgcn_s_setprio(0); } else { PG8_MMA(ai, 0, At, B0); PG8_MMA(ai, 1, At, B1); } } while (0)
#define PG8_WAIT_V(n) asm volatile("s_waitcnt vmcnt(" #n ")" ::: "memory")
#define PG8_WAIT_L(n) asm volatile("s_waitcnt lgkmcnt(" #n ")" ::: "memory")
#define PG8_BAR __builtin_amdgcn_s_barrier()
#define PG8_SCHED __builtin_amdgcn_sched_barrier(0)
    Unit cur, nxt; int ui = 0;
    if (!S.next(0, cur)) return;
    f32x4 acc[2][2][4][2];
#pragma unroll
    for (int a = 0; a < 2; ++a)
#pragma unroll
        for (int b = 0; b < 2; ++b)
#pragma unroll
            for (int m = 0; m < 4; ++m)
#pragma unroll
                for (int n = 0; n < 2; ++n) acc[a][b][m][n] = (f32x4){0.f, 0.f, 0.f, 0.f};
    bf16x8 At[4][2], B0[2][2], B1[2][2];
    v8i_t At8[4], B08[2], B18[2];
    const char* cA = (const char*)g.A + (size_t)cur.pm * tstepA + (size_t)cur.aoff * 2; const char* cB = (const char*)g.Bt + (size_t)cur.pn * tstepB + (size_t)cur.boff * 2;
    if constexpr (SP2) {
        PG8_STAGE(PG8_SB(0, 0), cB, voffB); PG8_STAGE(PG8_SB(0, 1), cB + hstepB, voffB); PG8_STAGE(PG8_SA(0, 0), cA, voffA); PG8_STAGE(PG8_SA(0, 1), cA + hstepA, voffA);
        if (wr == 1) PG8_BAR;
        PG8_WAIT_V(2); PG8_BAR;
        PG8_STAGE(PG8_SB(1, 0), cB + kstep, voffB); PG8_STAGE(PG8_SA(1, 0), cA + kstep, voffA); PG8_STAGE(PG8_SB(1, 1), cB + hstepB + kstep, voffB);
        PG8_WAIT_V(6); PG8_BAR;
    } else {
        PG8_STAGE(PG8_SB(0, 0), cB, voffB); PG8_STAGE(PG8_SA(0, 0), cA, voffA); PG8_STAGE(PG8_SB(0, 1), cB + hstepB, voffB); PG8_STAGE(PG8_SA(0, 1), cA + hstepA, voffA);
        if (wr == 1) PG8_BAR;
        PG8_WAIT_V(4); PG8_BAR;
        PG8_STAGE(PG8_SB(1, 0), cB + kstep, voffB); PG8_STAGE(PG8_SA(1, 0), cA + kstep, voffA); PG8_STAGE(PG8_SB(1, 1), cB + hstepB + kstep, voffB);
        PG8_WAIT_V(6); PG8_BAR;
    }
    for (;;) {
        const bool has_next = S.next(ui + 1, nxt);
        const char* nA = has_next ? (const char*)g.A + (size_t)nxt.pm * tstepA + (size_t)nxt.aoff * 2 : cA; const char* nB = has_next ? (const char*)g.Bt + (size_t)nxt.pn * tstepB + (size_t)nxt.boff * 2 : cB;
        const int nt = cur.nt;
        for (int t = 0; t < nt; t += 2) {
            const bool last = (t == nt - 2);
            const char* a1 = cA + (size_t)(t + 1) * kstep;
            const char* a2 = last ? nA : cA + (size_t)(t + 2) * kstep; const char* b2 = last ? nB : cB + (size_t)(t + 2) * kstep;
            const char* a3 = a2 + kstep; const char* b3 = b2 + kstep;
            if constexpr (SP2) {
#define PG8_S1 PG8_STAGE(PG8_SA(1, 1), a1 + hstepA, voffA)
#define PG8_S2 do { PG8_STAGE(PG8_SB(0, 0), b2, voffB); PG8_STAGE(PG8_SB(0, 1), b2 + hstepB, voffB); PG8_STAGE(PG8_SA(0, 0), a2, voffA); } while (0)
#define PG8_S3 PG8_STAGE(PG8_SA(0, 1), a2 + hstepA, voffA)
#define PG8_S4 do { PG8_STAGE(PG8_SB(1, 0), b3, voffB); PG8_STAGE(PG8_SB(1, 1), b3 + hstepB, voffB); PG8_STAGE(PG8_SA(1, 0), a3, voffA); } while (0)
            PG8_LDB(B0, 0, 0); PG8_LDB(B1, 0, 1); PG8_SCHED; PG8_LDA(At, 0, 0); PG8_S1;
            PG8_WAIT_V(8); PG8_WAIT_L(0); PG8_BAR; PG8_MMAP(0, 0, 0); PG8_BAR; PG8_SCHED;
            PG8_LDA(At, 0, 1); PG8_S2;
            PG8_WAIT_V(8); PG8_WAIT_L(0); PG8_BAR; PG8_MMAP(1, 0, 1); PG8_BAR; PG8_SCHED;
            PG8_LDB(B0, 1, 0); PG8_LDB(B1, 1, 1); PG8_SCHED; PG8_LDA(At, 1, 0); PG8_S3;
            PG8_WAIT_V(8); PG8_WAIT_L(0); PG8_BAR; PG8_MMAP(0, 1, 0); PG8_BAR; PG8_SCHED;
            PG8_LDA(At, 1, 1); PG8_S4;
            PG8_WAIT_V(8); PG8_WAIT_L(0); PG8_BAR; PG8_MMAP(1, 1, 1); PG8_BAR; PG8_SCHED;
            } else {
            PG8_LDB(B0, 0, 0); PG8_SCHED; PG8_LDA(At, 0, 0); PG8_STAGE(PG8_SA(1, 1), a1 + hstepA, voffA);
            PG8_WAIT_L(8); PG8_BAR; PG8_WAIT_L(0); PG8_MMA(0, 0, At, B0); PG8_BAR; PG8_SCHED;
            PG8_LDB(B1, 0, 1); PG8_STAGE(PG8_SB(0, 0), b2, voffB);
            PG8_BAR; PG8_WAIT_L(0); PG8_MMA(0, 1, At, B1); PG8_BAR;
            PG8_LDA(At, 0, 1); PG8_STAGE(PG8_SA(0, 0), a2, voffA);
            PG8_BAR; PG8_WAIT_L(0); PG8_MMA(1, 0, At, B0); PG8_BAR; PG8_SCHED;
            PG8_STAGE(PG8_SB(0, 1), b2 + hstepB, voffB);
            PG8_WAIT_V(6); PG8_BAR; PG8_MMA(1, 1, At, B1); PG8_BAR;
            PG8_LDB(B0, 1, 0); PG8_SCHED; PG8_LDA(At, 1, 0); PG8_STAGE(PG8_SA(0, 1), a2 + hstepA, voffA);
            PG8_WAIT_L(8); PG8_BAR; PG8_WAIT_L(0); PG8_MMA(0, 0, At, B0); PG8_BAR; PG8_SCHED;
            PG8_LDB(B1, 1, 1); PG8_STAGE(PG8_SB(1, 0), b3, voffB);
            PG8_BAR; PG8_WAIT_L(0); PG8_MMA(0, 1, At, B1); PG8_BAR;
            PG8_LDA(At, 1, 1); PG8_STAGE(PG8_SA(1, 0), a3, voffA);
            PG8_BAR; PG8_WAIT_L(0); PG8_MMA(1, 0, At, B0); PG8_BAR; PG8_SCHED;
            PG8_STAGE(PG8_SB(1, 1), b3 + hstepB, voffB);
            PG8_WAIT_V(6); PG8_BAR; PG8_MMA(1, 1, At, B1); PG8_BAR;
            }
        }
        if constexpr (ALIGN_EPI) { if (wr == 0) PG8_BAR; }
        { const int l2_ = lane_id(); E(acc, cur, wr, wc, l2_ & 15, l2_ >> 4); }
        if (!has_next) break;
#pragma unroll
        for (int a = 0; a < 2; ++a)
#pragma unroll
            for (int b = 0; b < 2; ++b)
#pragma unroll
                for (int m = 0; m < 4; ++m)
#pragma unroll
                    for (int n = 0; n < 2; ++n) acc[a][b][m][n] = (f32x4){0.f, 0.f, 0.f, 0.f};
        cur = nxt; cA = nA; cB = nB; ++ui;
        if constexpr (ALIGN_EPI) { if (wr == 1) PG8_BAR; }
    }
    PG8_WAIT_V(0);
    if constexpr (!ALIGN_EPI) { if (wr == 0) PG8_BAR; }
    PG8_BAR;
#undef PG8_SA
#undef PG8_SB
#undef PG8_STAGE
#undef PG8_LDA
#undef PG8_CAT
#undef PG8_LD8
#undef PG8_F8
#undef PG8_MMA2
#undef PG8_MMA2S
#undef PG8_S1
#undef PG8_S2
#undef PG8_S3
#undef PG8_S4
#undef PG8_MMAP
#undef PG8_LDB
#undef PG8_MMA
#undef PG8_WAIT_V
#undef PG8_WAIT_L
#undef PG8_BAR
#undef PG8_SCHED
}
}

#define MFMA32(a, b, c) __builtin_amdgcn_mfma_f32_32x32x16_bf16((a), (b), (c), 0, 0, 0)
__device__ __forceinline__ s16x4 vtr(LAS const char* p) { return __builtin_bit_cast(s16x4, __builtin_amdgcn_ds_read_tr16_b64_v4i16((LAS v4i16_t*)p)); }
__device__ __forceinline__ int crow(int r, int hi) { return (r & 3) + 8 * (r >> 2) + 4 * hi; }
constexpr int ALDS_K = 0, ALDS_V = 65536, ALDS_BIAS = 131072;

struct UDesc {
    int type;
    const bf16_t* qp; const bf16_t* kp; const bf16_t* vp;
    long tstride, sstride;
    int nh, Ld, q0, QB, HALF, nsub;
    const float* bias;
    const float* sink;
    bf16_t* op; long o_tstride, o_sstride;
    float* lsep; long l_tstride, l_sstride;
};
__device__ __forceinline__ void stage_issue(const UDesc& d, const int wave, u32x4 (&kr)[8], u32x4 (&vr)[8], float (&bv)[3]) {
    const int tid = wave * 64 + lane_id();
    if (d.type == 0) {
        const int c = tid & 15;
#pragma unroll
        for (int j = 0; j < 8; ++j) { const size_t off = (size_t)(j * 32 + (tid >> 4)) * 1024 + c * 8; kr[j] = *(const u32x4*)(d.kp + off); vr[j] = *(const u32x4*)(d.vp + off); }
    } else {
        const int c = tid & 7, NK = d.QB + 2 * d.HALF, nb = d.nh * (2 * d.HALF + 64);
#pragma unroll
        for (int j = 0; j < 8; ++j) { const int r = j * 64 + (tid >> 3); int sub = r / NK; const int i = r - sub * NK; sub = sub < d.nsub ? sub : d.nsub - 1;
            int idx = d.q0 - d.HALF + i; idx = idx < 0 ? 0 : (idx >= d.Ld ? d.Ld - 1 : idx);
            const size_t off = (size_t)sub * d.sstride + (size_t)idx * d.tstride + c * 8;
            kr[j] = *(const u32x4*)(d.kp + off); vr[j] = *(const u32x4*)(d.vp + off); }
#pragma unroll
        for (int t = 0; t < 3; ++t) { const int i = tid + 512 * t; bv[t] = d.bias[i < nb ? i : nb - 1]; }
    }
}
__device__ __forceinline__ void stage_commit(const UDesc& d, LAS char* lds, const int wave, const u32x4 (&kr)[8], const u32x4 (&vr)[8], const float (&bv)[3]) {
    const int tid = wave * 64 + lane_id();
    LAS char* Kl = lds + ALDS_K; LAS char* Vl = lds + ALDS_V;
    if (d.type == 0) {
        const int c = tid & 15;
#pragma unroll
        for (int j = 0; j < 8; ++j) { const int r = j * 32 + (tid >> 4);
            *(LAS u32x4*)(Kl + r * 256 + ((c ^ (r & 15)) << 4)) = kr[j];
            *(LAS u32x4*)(Vl + (c >> 2) * 16384 + r * 64 + (c & 3) * 16) = vr[j]; }
    } else {
        const int c = tid & 7, nb = d.nh * (2 * d.HALF + 64);
#pragma unroll
        for (int j = 0; j < 8; ++j) { const int r = j * 64 + (tid >> 3);
            *(LAS u32x4*)(Kl + r * 128 + ((c ^ ((r >> 1) & 7)) << 4)) = kr[j];
            *(LAS u32x4*)(Vl + (c >> 2) * 32768 + r * 64 + (c & 3) * 16) = vr[j]; }
        LAS float* Bl = (LAS float*)(lds + ALDS_BIAS);
#pragma unroll
        for (int t = 0; t < 3; ++t) { const int i = tid + 512 * t; if (i < nb) Bl[i] = bv[t]; }
        if (tid < 64) ((LAS float*)(lds + ALDS_BIAS + 6144))[tid] = -1e30f;
    }
}

__device__ __forceinline__ unsigned cvtpk(float lo, float hi) { f32x2_t v = {lo, hi}; bf16x2_t b = __builtin_convertvector(v, bf16x2_t); return __builtin_bit_cast(unsigned, b); }
__device__ __forceinline__ float xhalf_max(float v) { auto rr = __builtin_amdgcn_permlane32_swap(__float_as_uint(v), __float_as_uint(v), false, false); return fmaxf(__uint_as_float(rr[0]), __uint_as_float(rr[1])); }
__device__ __forceinline__ float xhalf_sum(float v) { auto rr = __builtin_amdgcn_permlane32_swap(__float_as_uint(v), __float_as_uint(v), false, false); return __uint_as_float(rr[0]) + __uint_as_float(rr[1]); }
__device__ __forceinline__ float max16(const f32x16& p) {
    float a = fmaxf(fmaxf(p[0], p[1]), p[2]), b = fmaxf(fmaxf(p[3], p[4]), p[5]);
    a = fmaxf(fmaxf(a, p[6]), p[7]); b = fmaxf(fmaxf(b, p[8]), p[9]); a = fmaxf(fmaxf(a, p[10]), p[11]); b = fmaxf(fmaxf(b, p[12]), p[13]);
    a = fmaxf(fmaxf(a, p[14]), p[15]); return fmaxf(a, b);
}
constexpr int ALDS_NEG = ALDS_BIAS + 6144;
template <int NKT, int DH, bool HASB>
__device__ __forceinline__ void attn_scores(LAS const char* Kl, const int krow0, LAS const float* bl, LAS const float* negl, const int kt_lo, const int kt_hi,
                                            const bf16x8 (&qf)[DH], const int h, f32x16 (&S)[NKT]) {
    const int sw = DH == 4 ? ((krow0 >> 1) & 7) : (krow0 & 15);
    LAS const char* kbase[DH];
#pragma unroll
    for (int d0 = 0; d0 < DH; ++d0) kbase[d0] = Kl + krow0 * (DH * 32) + (((2 * d0 + h) ^ sw) << 4);
    constexpr int KTS = 32 * DH * 32;
    constexpr bool PF = (DH == 4);
    bf16x8 kf[DH], kfn[DH];
#pragma unroll
    for (int d0 = 0; d0 < DH; ++d0) kf[d0] = *(LAS const bf16x8*)(kbase[d0]);
    if (HASB) { LAS const float* bt = (0 >= kt_lo && 0 < kt_hi) ? bl : negl;
#pragma unroll
        for (int i = 0; i < 16; ++i) S[0][i] = bt[(i & 3) + 8 * (i >> 2)]; }
    else {
#pragma unroll
        for (int i = 0; i < 16; ++i) S[0][i] = 0.f; }
#pragma unroll
    for (int kt = 0; kt < NKT; ++kt) {
        if (!PF && kt > 0) {
#pragma unroll
            for (int d0 = 0; d0 < DH; ++d0) kf[d0] = *(LAS const bf16x8*)(kbase[d0] + kt * KTS);
        }
        if (!PF) __builtin_amdgcn_sched_barrier(0);
        if (kt + 1 < NKT) {
            if (PF) {
#pragma unroll
                for (int d0 = 0; d0 < DH; ++d0) kfn[d0] = *(LAS const bf16x8*)(kbase[d0] + (kt + 1) * KTS);
            }
            if (HASB) { LAS const float* bt = (kt + 1 >= kt_lo && kt + 1 < kt_hi) ? bl + 32 * (kt + 1) : negl;
#pragma unroll
                for (int i = 0; i < 16; ++i) S[kt + 1][i] = bt[(i & 3) + 8 * (i >> 2)]; }
            else {
#pragma unroll
                for (int i = 0; i < 16; ++i) S[kt + 1][i] = 0.f; }
        }
#pragma unroll
        for (int d0 = 0; d0 < DH; ++d0) S[kt] = MFMA32(kf[d0], qf[d0], S[kt]);
        if (PF && kt + 1 < NKT) {
#pragma unroll
            for (int d0 = 0; d0 < DH; ++d0) kf[d0] = kfn[d0];
        }
        asm volatile("" : "+v"(S[kt]) :: "memory");
        __builtin_amdgcn_sched_barrier(0);
    }
}
template <int NKT, int DH>
__device__ __forceinline__ void attn_finish(f32x16 (&S)[NKT], LAS const char* Vl, const int vrow0, const int vplane, const float sinkv, const bool has_sink, const int lane,
                                            f32x16 (&o)[DH / 2], float& scale_out, float& lse_out) {
    const int h = lane >> 5;
    float mx = max16(S[0]);
#pragma unroll
    for (int kt = 1; kt < NKT; ++kt) mx = fmaxf(mx, max16(S[kt]));
    mx = xhalf_max(mx);
    if (has_sink) mx = fmaxf(mx, sinkv);
    float l = 0.f;
    u32x4 pw[NKT][2];
#pragma unroll
    for (int kt = 0; kt < NKT; ++kt) {
        float ls = 0.f;
#pragma unroll
        for (int i = 0; i < 16; ++i) { S[kt][i] = __builtin_amdgcn_exp2f(S[kt][i] - mx); ls += S[kt][i]; }
        l += ls;
#pragma unroll
        for (int q = 0; q < 4; ++q) { pw[kt][0][q] = cvtpk(S[kt][2 * q], S[kt][2 * q + 1]); pw[kt][1][q] = cvtpk(S[kt][8 + 2 * q], S[kt][9 + 2 * q]); }
        asm volatile("" : "+v"(pw[kt][0]), "+v"(pw[kt][1]), "+v"(l));
        __builtin_amdgcn_sched_barrier(0);
    }
#pragma unroll
    for (int db = 0; db < DH / 2; ++db)
#pragma unroll
        for (int i = 0; i < 16; ++i) o[db][i] = 0.f;
    LAS const char* vb = Vl + (vrow0 + 4 * h + ((lane & 15) >> 2)) * 64 + ((lane >> 4) & 1) * 32 + (lane & 3) * 8;
    s16x4 va[DH / 2][4], vn[DH / 2][4];
#pragma unroll
    for (int db = 0; db < DH / 2; ++db)
#pragma unroll
        for (int q = 0; q < 4; ++q) va[db][q] = vtr(vb + db * vplane + q * 512);
    __builtin_amdgcn_sched_barrier(0);
#pragma unroll
    for (int kt = 0; kt < NKT; ++kt) {
        if (kt + 1 < NKT) {
#pragma unroll
            for (int db = 0; db < DH / 2; ++db)
#pragma unroll
                for (int q = 0; q < 4; ++q) vn[db][q] = vtr(vb + (kt + 1) * 2048 + db * vplane + q * 512);
        }
        const bf16x8 pb0 = __builtin_bit_cast(bf16x8, pw[kt][0]), pb1 = __builtin_bit_cast(bf16x8, pw[kt][1]);
#pragma unroll
        for (int db = 0; db < DH / 2; ++db) {
            o[db] = MFMA32(__builtin_shufflevector(va[db][0], va[db][1], 0, 1, 2, 3, 4, 5, 6, 7), pb0, o[db]);
            o[db] = MFMA32(__builtin_shufflevector(va[db][2], va[db][3], 0, 1, 2, 3, 4, 5, 6, 7), pb1, o[db]);
        }
#pragma unroll
        for (int db = 0; db < DH / 2; ++db)
#pragma unroll
            for (int q = 0; q < 4; ++q) va[db][q] = vn[db][q];
#pragma unroll
        for (int db = 0; db < DH / 2; ++db) asm volatile("" : "+v"(o[db]) :: "memory");
        __builtin_amdgcn_sched_barrier(0);
    }
    l = xhalf_sum(l);
    if (has_sink) l += __builtin_amdgcn_exp2f(sinkv - mx);
    scale_out = 1.0f / l; lse_out = mx + __builtin_amdgcn_logf(l);
}
constexpr int ALDS_OST = 139264;
template <int NDB>
__device__ __forceinline__ void store_o_tile(LAS char* stg, const f32x16 (&o)[NDB], const float scale, bf16_t* tile_base, const long row_stride, const int lane) {
    const int ql = lane & 31, h = lane >> 5;
    LAS char* wp = stg + ql * 64 + 8 * h; const int wsw = (ql >> 1) & 3;
    const int r0 = lane >> 2, c = lane & 3;
#pragma unroll
    for (int db = 0; db < NDB; ++db) {
#pragma unroll
        for (int g4 = 0; g4 < 4; ++g4) { u32x2 w; w.x = cvtpk(o[db][4 * g4] * scale, o[db][4 * g4 + 1] * scale); w.y = cvtpk(o[db][4 * g4 + 2] * scale, o[db][4 * g4 + 3] * scale);
            *(LAS u32x2*)(wp + ((g4 ^ wsw) << 4)) = w; }
#pragma unroll
        for (int t = 0; t < 2; ++t) { const int r = t * 16 + r0; const u32x4 v = *(LAS const u32x4*)(stg + r * 64 + ((c ^ ((r >> 1) & 3)) << 4));
            *(u32x4*)(tile_base + (size_t)r * row_stride + db * 32 + c * 8) = v; }
    }
}
template <int NDB>
__device__ __forceinline__ void store_o_tile8(LAS char* stg, const f32x16 (&o)[NDB], const float scale, unsigned char* tile_base8, const long row_stride, const int lane) {
    const int ql = lane & 31, h = lane >> 5;
    LAS char* wp = stg + ql * 32 + 4 * h;
    const int r = lane >> 1, hf = lane & 1;
    const float s16 = scale * 16.0f;
#pragma unroll
    for (int db = 0; db < NDB; ++db) {
#pragma unroll
        for (int g4 = 0; g4 < 4; ++g4) *(LAS unsigned*)(wp + 8 * g4) = pk_fp8x4(o[db][4 * g4] * s16, o[db][4 * g4 + 1] * s16, o[db][4 * g4 + 2] * s16, o[db][4 * g4 + 3] * s16);
        const u32x4 v = *(LAS const u32x4*)(stg + r * 32 + hf * 16);
        *(u32x4*)(tile_base8 + (size_t)r * row_stride + db * 32 + hf * 16) = v;
    }
}
__device__ __forceinline__ const bf16_t* band_qrow(const UDesc& d, int wt, int ql, int h) {
    const int nq32 = d.QB >> 5; const int sub = wt / (d.nh * nq32), rem = wt - sub * (d.nh * nq32), hh = rem / nq32, qs = (rem - hh * nq32) * 32;
    return d.qp + (size_t)sub * d.sstride + (size_t)(d.q0 + qs + ql) * d.tstride + hh * 64 + 8 * h;
}
template <int NKT, bool OUT8>
__device__ __forceinline__ void band_compute(LAS char* lds, const UDesc& d, const int wave, bf16x8 (&qf)[4]) {
    const int lane = lane_id(), ql = lane & 31, h = lane >> 5;
    const int NK = d.QB + 2 * d.HALF, nbx = 2 * d.HALF + 64;
    LAS char* Kl = lds + ALDS_K; LAS char* Vl = lds + ALDS_V; LAS float* Bl = (LAS float*)(lds + ALDS_BIAS); LAS const float* negl = (LAS const float*)(lds + ALDS_NEG);
    const int nq32 = d.QB >> 5, ntiles = d.nsub * d.nh * nq32, nkt = (32 + 2 * d.HALF) >> 5;
    for (int wt = wave; wt < ntiles; wt += 8) {
        const int sub = wt / (d.nh * nq32), rem = wt - sub * (d.nh * nq32), hh = rem / nq32, qs = (rem - hh * nq32) * 32;
        const int qidx = d.q0 + qs + ql;
        LAS const float* bl = Bl + hh * nbx + 32 - ql + 4 * h;
        const int rbase = sub * NK;
        const int k0 = d.q0 - d.HALF + qs;
        int kt_lo = k0 < 0 ? (-k0) >> 5 : 0, kt_hi = (d.Ld - k0) >> 5; kt_hi = kt_hi < nkt ? kt_hi : nkt;
        f32x16 o[2]; float scale, lse2;
        const bool has_sink = d.sink != nullptr; const float sinkv = has_sink ? d.sink[hh] * 1.4426950408889634f : 0.f;
        const bf16_t* qnrow = band_qrow(d, wt + 8 < ntiles ? wt + 8 : wt, ql, h);
        { f32x16 S[NKT]; attn_scores<NKT, 4, true>(Kl, rbase + qs + ql, bl, negl, kt_lo, kt_hi, qf, h, S);
#pragma unroll
          for (int d0 = 0; d0 < 4; ++d0) qf[d0] = *(const bf16x8*)(qnrow + 16 * d0);
          attn_finish<NKT, 4>(S, Vl, rbase + qs, 32768, sinkv, has_sink, lane, o, scale, lse2); }
        if (OUT8) store_o_tile8<2>(lds + ALDS_OST + wave * 2048, o, scale, (unsigned char*)d.op + (size_t)sub * d.o_sstride + (size_t)(d.q0 + qs) * d.o_tstride + hh * 64, d.o_tstride, lane);
        else store_o_tile<2>(lds + ALDS_OST + wave * 2048, o, scale, d.op + (size_t)sub * d.o_sstride + (size_t)(d.q0 + qs) * d.o_tstride + hh * 64, d.o_tstride, lane);
        if (d.lsep && h == 0) d.lsep[(size_t)sub * d.l_sstride + (size_t)qidx * d.l_tstride] = lse2;
    }
    __syncthreads();
}

__device__ __forceinline__ void mem_compute(LAS char* lds, const UDesc& d, const int wave, bf16x8 (&qf)[8]) {
    const int lane = lane_id(), ql = lane & 31, h = lane >> 5;
    LAS char* Kl = lds + ALDS_K; LAS char* Vl = lds + ALDS_V;
    for (int wt = wave; wt < 32; wt += 8) {
        const int tok = wt * 32 + ql;
        const bf16_t* qnrow = d.qp + (size_t)((wt + 8 < 32 ? wt + 8 : wt) * 32 + ql) * NQKV + 8 * h;
        f32x16 o[4]; float scale, lse2;
        { f32x16 S[8]; attn_scores<8, 8, false>(Kl, ql, nullptr, nullptr, 0, 8, qf, h, S);
#pragma unroll
          for (int d0 = 0; d0 < 8; ++d0) qf[d0] = *(const bf16x8*)(qnrow + 16 * d0);
          attn_finish<8, 8>(S, Vl, 0, 16384, 0.f, false, lane, o, scale, lse2); }
        store_o_tile8<4>(lds + ALDS_OST + wave * 2048, o, scale, (unsigned char*)d.op + (size_t)(wt * 32) * (LDH * 2), LDH * 2, lane);
    }
    __syncthreads();
}

__device__ __forceinline__ void transpose_item(const float* W, int ldsrc, int c0, int nblk, bf16_t* WT, int ldd, int dcol, const float* g, int scale_mode, LAS float* scr, int item, int lane) {
    const int kb = item / nblk, nbi = item - kb * nblk, k0 = 64 * kb, n0 = 32 * nbi;
    float cs = 1.f;
    if (scale_mode == 1) { const int n = n0; cs = (n < 512 || (n >= 768 && n < 1536)) ? 0.125f * 1.4426950408889634f : (n >= 3072 ? 0.08838834764831845f * 1.4426950408889634f : 1.f); }
#pragma unroll 8
    for (int i = 0; i < 32; ++i) { const int kk = 2 * i + (lane >> 5); float v = W[(size_t)(k0 + kk) * ldsrc + c0 + n0 + (lane & 31)]; if (g) v *= g[k0 + kk]; scr[kk * 33 + (lane & 31)] = v * cs; }
    asm volatile("s_waitcnt lgkmcnt(0)" ::: "memory");
    const int c = lane & 7;
#pragma unroll
    for (int j = 0; j < 4; ++j) { const int n = (lane >> 3) + 8 * j; const LAS float* s = scr + (8 * c) * 33 + n;
        u32x4 o; o.x = pk2(s[0 * 33], s[1 * 33]); o.y = pk2(s[2 * 33], s[3 * 33]); o.z = pk2(s[4 * 33], s[5 * 33]); o.w = pk2(s[6 * 33], s[7 * 33]);
        *(u32x4*)(WT + (size_t)(n0 + n) * ldd + dcol + k0 + 8 * c) = o; }
    asm volatile("s_waitcnt lgkmcnt(0)" ::: "memory");
}
template <int NRW>
__device__ __forceinline__ void rms_rows_to_bf16(const float* const (&xrow)[NRW], bf16_t* const (&orow)[NRW], unsigned char* const (&o8row)[NRW], int lane) {
    f32x4 v[NRW][4];
#pragma unroll
    for (int r = 0; r < NRW; ++r)
#pragma unroll
        for (int j = 0; j < 4; ++j) v[r][j] = ((const f32x4*)xrow[r])[lane + 64 * j];
#pragma unroll
    for (int r = 0; r < NRW; ++r) { float s = 0.f;
#pragma unroll
        for (int j = 0; j < 4; ++j) s += (v[r][j].x * v[r][j].x + v[r][j].y * v[r][j].y) + (v[r][j].z * v[r][j].z + v[r][j].w * v[r][j].w);
        const float rstd = rsqrtf(wave_sum(s) * (1.f / DM) + EPS);
        if (orow[r]) { u32x2* o8 = (u32x2*)orow[r] + lane;
#pragma unroll
            for (int j = 0; j < 4; ++j) { u32x2 w; w.x = pk2(v[r][j].x * rstd, v[r][j].y * rstd); w.y = pk2(v[r][j].z * rstd, v[r][j].w * rstd); o8[64 * j] = w; } }
        if (o8row[r]) { unsigned* q8 = (unsigned*)o8row[r] + lane;
#pragma unroll
            for (int j = 0; j < 4; ++j) q8[64 * j] = pk_fp8x4(v[r][j].x * rstd, v[r][j].y * rstd, v[r][j].z * rstd, v[r][j].w * rstd); } }
}
__device__ __forceinline__ void transpose_item8(const float* W, int ldsrc, int c0, int nblk, unsigned char* W8, const float* g, int scale_mode, float mult, LAS float* scr, int item, int lane, int ldd = 1024, int dcol = 0) {
    const int kb = item / nblk, nbi = item - kb * nblk, k0 = 64 * kb, n0 = 32 * nbi;
    float cs = mult;
    if (scale_mode == 1) { const int n = n0; cs *= (n < 512 || (n >= 768 && n < 1536)) ? 0.125f * 1.4426950408889634f : (n >= 3072 ? 0.08838834764831845f * 1.4426950408889634f : 1.f); }
#pragma unroll 8
    for (int i = 0; i < 32; ++i) { const int kk = 2 * i + (lane >> 5); float v = W[(size_t)(k0 + kk) * ldsrc + c0 + n0 + (lane & 31)]; if (g) v *= g[k0 + kk]; scr[kk * 33 + (lane & 31)] = v * cs; }
    asm volatile("s_waitcnt lgkmcnt(0)" ::: "memory");
    const int c = lane & 7;
#pragma unroll
    for (int j = 0; j < 4; ++j) { const int n = (lane >> 3) + 8 * j; const LAS float* sp = scr + (8 * c) * 33 + n;
        u32x2 o; o.x = pk_fp8x4(sp[0 * 33], sp[1 * 33], sp[2 * 33], sp[3 * 33]); o.y = pk_fp8x4(sp[4 * 33], sp[5 * 33], sp[6 * 33], sp[7 * 33]);
        *(u32x2*)(W8 + (size_t)(n0 + n) * ldd + dcol + k0 + 8 * c) = o; }
    asm volatile("s_waitcnt lgkmcnt(0)" ::: "memory");
}

#ifndef REPMASK
#define REPMASK 0
#endif
#ifndef REPMASK
#define REPMASK 0
#endif
#define XB_TMO      128
#define XB_XCNT(j)  (256  + 64 * (j))
#define XB_XSUB(j)  (1280 + 64 * (j))
#define XB_XGEN(j)  (2304 + 64 * (j))
#define XB_TOP      3328
#define XB_TOPGEN   3392
#define XB_SPIN_CAP (1u << 22)
__device__ __forceinline__ unsigned xb_ld(unsigned* p)              { return __hip_atomic_load(p, __ATOMIC_RELAXED, __HIP_MEMORY_SCOPE_AGENT); }
__device__ __forceinline__ unsigned xb_add(unsigned* p, unsigned v) { return __hip_atomic_fetch_add(p, v, __ATOMIC_RELAXED, __HIP_MEMORY_SCOPE_AGENT); }
__device__ __forceinline__ unsigned xb_xcc_id() { return (unsigned)__builtin_amdgcn_s_getreg((3 << 11) | 20) & 0xFu; }
#define XB_SPIN(cond, bar) do { unsigned _sp = 0; while (cond) { __builtin_amdgcn_s_sleep(1); \
    if ((++_sp & 255u) == 0u) { if (xb_ld(&(bar)[XB_TMO])) break; if (_sp > XB_SPIN_CAP) { atomicAdd(&(bar)[XB_TMO], 1u); break; } } } } while (0)
struct XcdBarrier { unsigned* bar; unsigned x; volatile LAS unsigned* st; };
__device__ __forceinline__ void xcd_barrier_complete(unsigned* bar, unsigned x, unsigned& nloc, unsigned& nx) {
    const unsigned G = gridDim.x;
    unsigned sum, cnt, mine, sp = 0u;
    for (;;) {
        sum = 0u; cnt = 0u; mine = 0u;
#pragma unroll
        for (unsigned j = 0; j < 16; ++j) { const unsigned c = xb_ld(&bar[XB_XCNT(j)]); sum += c; cnt += (c > 0u) ? 1u : 0u; mine = (j == x) ? c : mine; }
        if (sum == G) break;
        __builtin_amdgcn_s_sleep(1);
        if ((++sp & 255u) == 0u) { if (xb_ld(&bar[XB_TMO])) break; if (sp > XB_SPIN_CAP) { atomicAdd(&bar[XB_TMO], 1u); break; } }
    }
    nloc = mine > 0u ? mine : 1u; nx = cnt > 0u ? cnt : 1u;
}
__device__ __forceinline__ void xcd_barrier(const XcdBarrier& b, const int wave) {
    asm volatile("s_waitcnt vmcnt(0)" ::: "memory");
    __syncthreads();
    if (wave == 0 && lane_id() == 0) {
        unsigned* bar = b.bar;
        __builtin_amdgcn_s_waitcnt(0);
        unsigned nloc = b.st[0], nx = b.st[1];
        if (nloc == 0u) { xcd_barrier_complete(bar, b.x, nloc, nx); b.st[0] = nloc; b.st[1] = nx; }
        const unsigned old = xb_add(&bar[XB_XSUB(b.x)], 1u);
        const unsigned gen = old / nloc;
        if (old + 1u == (gen + 1u) * nloc) {
            __builtin_amdgcn_fence(__ATOMIC_RELEASE, "agent");
            asm volatile("s_waitcnt vmcnt(0)" ::: "memory");
            const unsigned og = xb_add(&bar[XB_TOP], 1u);
            const unsigned tg = og / nx;
            if (og + 1u == (tg + 1u) * nx) xb_add(&bar[XB_TOPGEN], 1u);
            else XB_SPIN(xb_ld(&bar[XB_TOPGEN]) == tg, bar);
            __builtin_amdgcn_fence(__ATOMIC_ACQUIRE, "agent");
            xb_add(&bar[XB_XGEN(b.x)], 1u);
            asm volatile("s_waitcnt vmcnt(0)" ::: "memory");
        } else {
            XB_SPIN(xb_ld(&bar[XB_XGEN(b.x)]) == gen, bar);
            __builtin_amdgcn_fence(__ATOMIC_ACQUIRE, "agent");
            asm volatile("s_waitcnt vmcnt(0)" ::: "memory");
        }
    }
    __syncthreads();
}

struct Args { const float* in[18]; float* out; unsigned char* ws; };

__global__ void __launch_bounds__(512, 2) fwd_megakernel(Args args) {
    extern __shared__ __attribute__((aligned(16))) unsigned char lds_raw[];
    LAS unsigned char* lds = (LAS unsigned char*)lds_raw;
    cg::grid_group grid = cg::this_grid();
    const int wave = __builtin_amdgcn_readfirstlane(threadIdx.x >> 6);
    const int G = gridDim.x, bx = blockIdx.x;
    XcdBarrier xbar; xbar.bar = (unsigned*)(args.ws + 32768); xbar.x = xb_xcc_id(); xbar.st = (volatile LAS unsigned*)(lds + 138240);
    if (threadIdx.x == 0) { xbar.st[0] = 0u; xbar.st[1] = 0u; (void)xb_add(&xbar.bar[XB_XCNT(xbar.x)], 1u); }
    unsigned char* ws = args.ws;
    const float* x_p = args.in[0]; const float* x_s = args.in[1]; const float* mem_p = args.in[2]; const float* mem_s = args.in[3];
    const float* rel_bias = args.in[4]; const float* norm1_g = args.in[5]; const float* w_in = args.in[6]; const float* mem_norm_g = args.in[7];
    const float* w_mem_kv = args.in[8]; const float* sink_logit = args.in[9]; const float* w_br_a = args.in[10]; const float* w_br_b = args.in[11];
    const float* w_br_m = args.in[12]; const float* w_out = args.in[13]; const float* norm2_g = args.in[14]; const float* w_up = args.in[15];
    const float* w_down = args.in[16]; const float* final_g = args.in[17];
    float* out = args.out;
    float* biasA = (float*)(ws + WS_BIASA); float* biasB = (float*)(ws + WS_BIASB);
    bf16_t* Wqkv = (bf16_t*)(ws + WS_WQKV); bf16_t* W3 = (bf16_t*)(ws + WS_W3); bf16_t* Wmem = (bf16_t*)(ws + WS_WMEM); bf16_t* Wout = (bf16_t*)(ws + WS_WOUT);
    bf16_t* Wup = (bf16_t*)(ws + WS_WUP); bf16_t* Wdn = (bf16_t*)(ws + WS_WDN);
    bf16_t* memn = (bf16_t*)(ws + WS_MEMN); bf16_t* mkv = (bf16_t*)(ws + WS_MKV); float* ssq = (float*)(ws + WS_SSQ); float* lse = (float*)(ws + WS_LSE);
    bf16_t* qkv = (bf16_t*)(ws + WS_QKV); bf16_t* hcat = (bf16_t*)(ws + WS_HCAT); bf16_t* x1b = (bf16_t*)(ws + WS_X1B); bf16_t* merged = (bf16_t*)(ws + WS_MERGED);
    bf16_t* hid = (bf16_t*)(ws + WS_HID);
    unsigned char* h8 = (unsigned char*)out + 160 * MiB; unsigned char* Wg8 = (unsigned char*)out + 248 * MiB; unsigned char* Wqkv8 = (unsigned char*)out + 252 * MiB;
    bf16_t* og = (bf16_t*)((unsigned char*)out + DO_OG);

    for (int rep_ = 0; rep_ < 1 + ((REPMASK >> 0) & 1); ++rep_) {
        const int lane = lane_id(), tid = wave * 64 + lane;
        LAS float* scr = (LAS float*)(lds + wave * 16384);
        const int gw = bx * 8 + wave, NGW = G * 8;
        constexpr int I1 = 16 * 112, I2 = 16 * 32, I3 = 8 * 32, I4 = 4 * 32, I6 = 16 * 32, I8 = 16 * 128, I9 = 64 * 32;
        constexpr int NITEMS = I1 + 3 * I2 + I3 + I4 + I3 + I6 + I6 + I8 + I9;
        for (int it = gw; it < NITEMS; it += NGW) {
            int r = it;
            if (r < I1) { transpose_item8(w_in, NIN, 0, 112, Wqkv8, norm1_g, 1, 128.0f, scr, r, lane); continue; } r -= I1;
            if (r < 3 * I2) { const int br = r / I2; transpose_item8(w_in, NIN, NQKV + 1024 * br, 32, (unsigned char*)W3, norm1_g, 0, 32.0f, scr, r - br * I2, lane, 4352, 1024 * br); continue; } r -= 3 * I2;
            if (r < I3) { transpose_item8(w_br_a, 1024, 0, 32, (unsigned char*)W3, nullptr, 0, 32.0f, scr, r, lane, 4352, 3072); continue; } r -= I3;
            if (r < I4) { transpose_item8(w_br_b, 1024, 0, 32, (unsigned char*)W3, nullptr, 0, 32.0f, scr, r, lane, 4352, 3072 + 512); continue; } r -= I4;
            if (r < I3) { transpose_item8(w_br_m, 1024, 0, 32, (unsigned char*)W3, nullptr, 0, 32.0f, scr, r, lane, 4352, 3072 + 768); continue; } r -= I3;
            if (r < I6) { transpose_item(w_mem_kv, 1024, 0, 32, Wmem, 1024, 0, mem_norm_g, 0, scr, r, lane); continue; } r -= I6;
            if (r < I6) { transpose_item8(w_out, 1024, 0, 32, (unsigned char*)Wout, nullptr, 0, 32.0f, scr, r, lane); continue; } r -= I6;
            if (r < I8) { transpose_item(w_up, DFF, 0, 128, Wup, 1024, 0, norm2_g, 0, scr, r, lane); continue; } r -= I8;
            transpose_item(w_down, 1024, 0, 32, Wdn, DFF, 0, nullptr, 0, scr, r, lane);
        }
        for (int row = gw; row < TT; row += 4 * NGW) {
            const float* xr[4]; bf16_t* orw[4]; unsigned char* o8[4];
#pragma unroll
            for (int r = 0; r < 4; ++r) { int rw = row + r * NGW; rw = rw < TT ? rw : row; xr[r] = rw < TP ? x_p + (size_t)rw * DM : x_s + (size_t)(rw - TP) * DM; orw[r] = nullptr; o8[r] = (unsigned char*)hcat + (size_t)rw * (LDH * 2); }
            rms_rows_to_bf16<4>(xr, orw, o8, lane);
        }
        for (int row = gw; row < TMEM; row += NGW) {
            const float* xr[1] = {row < 32 * NMEM ? mem_p + (size_t)row * DM : mem_s + (size_t)(row - 32 * NMEM) * DM}; bf16_t* orw[1] = {memn + (size_t)row * DM}; unsigned char* o8[1] = {nullptr};
            rms_rows_to_bf16<1>(xr, orw, o8, lane);
        }
        const int gt = bx * 512 + tid;
        if (gt < 8 * NBA) { const int hd = gt / NBA, o = gt - hd * NBA - 32; biasA[gt] = (o >= 0 && o <= 256) ? rel_bias[t5_bucket(o - 128) * 20 + hd] * 1.4426950408889634f : -1e30f; }
        else if (gt < 8 * NBA + 12 * NBB) { const int e = gt - 8 * NBA, hd = e / NBB, o = e - hd * NBB - 32, gi = hd >> 2; const int dil = gi == 0 ? 1 : (gi == 1 ? 4 : 16);
            biasB[e] = (o >= 0 && o <= 128) ? rel_bias[t5_bucket(dil * (o - 64)) * 20 + 8 + hd] * 1.4426950408889634f : -1e30f; }
    }
    if (args.out == nullptr) grid.sync();
    xcd_barrier(xbar, wave);

    for (int rep_ = 0; rep_ < 1 + ((REPMASK >> 1) & 1); ++rep_) {
        int nt8 = 8; asm volatile("" : "+s"(nt8));
        { pg8::Gemm g{hcat, (const bf16_t*)Wqkv8, LDH, 512}; pg8::SchedQkv S{bx, nt8}; pg8::EpiStoreBf16 E{qkv, NQKV, 1.0f / 128.0f};
          pg8::gemm_phase<pg8::EpiStoreBf16, pg8::SchedQkv, true, true, true>(lds, g, S, E, wave); }
        { pg8::Gemm g{memn, Wmem, 1024, 1024}; pg8::Sched<1> S{TMEM / 256, 4, G, bx >= 96 ? bx - 96 : (1 << 20), 16}; pg8::EpiStoreBf16 E{mkv, 1024, 1.0f};
          pg8::gemm_phase<pg8::EpiStoreBf16, pg8::Sched<1>, true, true>(lds, g, S, E, wave); }
    }
    xcd_barrier(xbar, wave);

    for (int rep_ = 0; rep_ < 1 + ((REPMASK >> 2) & 1); ++rep_) {
        constexpr int NU_M = NB * 4 * 2, NU_A = NB * 2 * 8, NU_B = 3 * NB * 4 * 8, NU = NU_M + NU_A + NU_B;
        auto decode = [&](int u) -> UDesc {
            UDesc d;
            if (u < NU_M) {
                const int b = u >> 3, hm = (u >> 1) & 3, qc = u & 1; const size_t tok0 = (size_t)b * SEQ + qc * 1024;
                d.type = 0; d.kp = mkv + (size_t)b * NMEM * 1024 + hm * 128; d.vp = d.kp + 512; d.qp = qkv + tok0 * NQKV + 3072 + hm * 128; d.op = (bf16_t*)((unsigned char*)hcat + tok0 * (LDH * 2) + 2048 + 768 + hm * 128);
                d.tstride = NQKV; d.sstride = 0; d.nh = 1; d.Ld = 256; d.q0 = 0; d.QB = 1024; d.HALF = 0; d.nsub = 1; d.bias = biasA; d.sink = nullptr;
                d.o_tstride = LDH; d.o_sstride = 0; d.lsep = nullptr; d.l_tstride = 0; d.l_sstride = 0;
            } else if (u < NU_M + NU_A) {
                const int e = u - NU_M, b = e >> 4, kvh = (e >> 3) & 1, qb = e & 7;
                const bf16_t* base = qkv + (size_t)b * SEQ * NQKV;
                d.type = 1; d.qp = base + kvh * 256; d.kp = base + 512 + kvh * 64; d.vp = base + 640 + kvh * 64; d.tstride = NQKV; d.sstride = 0;
                d.nh = 4; d.Ld = SEQ; d.q0 = qb * 256; d.QB = 256; d.HALF = 128; d.nsub = 1;
                d.bias = biasA + kvh * 4 * NBA; d.sink = sink_logit + kvh * 4;
                d.op = (bf16_t*)((unsigned char*)hcat + (size_t)b * SEQ * (LDH * 2) + 2048 + kvh * 256); d.o_tstride = LDH * 2; d.o_sstride = 0; d.lsep = nullptr; d.l_tstride = 0; d.l_sstride = 0;
            } else {
                const int e = u - NU_M - NU_A, gi = e / (NB * 32), e2 = e - gi * (NB * 32), b = e2 >> 5, j = (e2 >> 3) & 3, blk = e2 & 7;
                const int hB = 4 * gi + j;
                int r, q0, dil;
                if (gi == 0) { dil = 1; r = 0; q0 = blk * 256; d.QB = 256; d.nsub = 1; d.Ld = 2048; }
                else if (gi == 1) { dil = 4; r = blk >> 1; q0 = (blk & 1) * 256; d.QB = 256; d.nsub = 1; d.Ld = 512; }
                else { dil = 16; r = blk * 2; q0 = 0; d.QB = 128; d.nsub = 2; d.Ld = 128; }
                const size_t tok0 = (size_t)b * SEQ + r;
                const bf16_t* base = qkv + tok0 * NQKV;
                d.type = 1; d.qp = base + 768 + hB * 64; d.kp = base + 1536 + hB * 64; d.vp = base + 2304 + hB * 64; d.tstride = (long)dil * NQKV; d.sstride = NQKV;
                d.nh = 1; d.q0 = q0; d.HALF = 64;
                d.bias = biasB + hB * NBB; d.sink = nullptr;
                d.op = og + ((size_t)gi * TT + tok0) * 256 + j * 64; d.o_tstride = (long)dil * 256; d.o_sstride = 256;
                d.lsep = lse + ((size_t)gi * TT + tok0) * 4 + j; d.l_tstride = (long)dil * 4; d.l_sstride = 4;
            }
            return d;
        };
        int u = bx;
        for (; u < NU_M; u += G) {
            const UDesc cur = decode(u);
            u32x4 kr[8], vr[8]; float bv[3]; stage_issue(cur, wave, kr, vr, bv);
            bf16x8 qf[8]; { const int lane = lane_id(); const bf16_t* qrow = cur.qp + (size_t)(wave * 32 + (lane & 31)) * NQKV + 8 * (lane >> 5);
#pragma unroll
              for (int d0 = 0; d0 < 8; ++d0) qf[d0] = *(const bf16x8*)(qrow + 16 * d0); }
            stage_commit(cur, (LAS char*)lds, wave, kr, vr, bv); __syncthreads();
            mem_compute((LAS char*)lds, cur, wave, qf);
        }
        for (; u < NU_M + NU_A; u += G) {
            const UDesc cur = decode(u);
            u32x4 kr[8], vr[8]; float bv[3]; stage_issue(cur, wave, kr, vr, bv);
            bf16x8 qf[4]; { const int lane = lane_id(); const bf16_t* qrow = band_qrow(cur, wave, lane & 31, lane >> 5);
#pragma unroll
              for (int d0 = 0; d0 < 4; ++d0) qf[d0] = *(const bf16x8*)(qrow + 16 * d0); }
            stage_commit(cur, (LAS char*)lds, wave, kr, vr, bv); __syncthreads();
            band_compute<9, true>((LAS char*)lds, cur, wave, qf);
        }
        for (; u < NU; u += G) {
            const UDesc cur = decode(u);
            u32x4 kr[8], vr[8]; float bv[3]; stage_issue(cur, wave, kr, vr, bv);
            bf16x8 qf[4]; { const int lane = lane_id(); const bf16_t* qrow = band_qrow(cur, wave, lane & 31, lane >> 5);
#pragma unroll
              for (int d0 = 0; d0 < 4; ++d0) qf[d0] = *(const bf16x8*)(qrow + 16 * d0); }
            stage_commit(cur, (LAS char*)lds, wave, kr, vr, bv); __syncthreads();
            band_compute<5, false>((LAS char*)lds, cur, wave, qf);
        }
    }
    xcd_barrier(xbar, wave);

    for (int rep_ = 0; rep_ < 1 + ((REPMASK >> 3) & 1); ++rep_) {
        const int tid = wave * 64 + lane_id();
        const size_t nitems = (size_t)TT * 32;
        for (size_t it = (size_t)bx * 512 + tid; it < nitems; it += (size_t)G * 512) {
            const size_t tok = it >> 5; const int j = (int)(it >> 3) & 3, c = (int)it & 7;
            const float l0 = lse[tok * 4 + j], l1 = lse[((size_t)TT + tok) * 4 + j], l2 = lse[((size_t)2 * TT + tok) * 4 + j];
            const float mx = fmaxf(l0, fmaxf(l1, l2)); float w0 = __builtin_amdgcn_exp2f(l0 - mx), w1 = __builtin_amdgcn_exp2f(l1 - mx), w2 = __builtin_amdgcn_exp2f(l2 - mx); const float inv = 1.0f / (w0 + w1 + w2);
            w0 *= inv; w1 *= inv; w2 *= inv;
            const u32x4 a = *(const u32x4*)(og + tok * 256 + j * 64 + c * 8), bq = *(const u32x4*)(og + ((size_t)TT + tok) * 256 + j * 64 + c * 8), cq = *(const u32x4*)(og + ((size_t)2 * TT + tok) * 256 + j * 64 + c * 8);
            float f[8];
#pragma unroll
            for (int e = 0; e < 4; ++e) { f[2 * e] = w0 * bf2f((unsigned short)(a[e] & 0xffff)) + w1 * bf2f((unsigned short)(bq[e] & 0xffff)) + w2 * bf2f((unsigned short)(cq[e] & 0xffff));
                f[2 * e + 1] = w0 * bf2f((unsigned short)(a[e] >> 16)) + w1 * bf2f((unsigned short)(bq[e] >> 16)) + w2 * bf2f((unsigned short)(cq[e] >> 16)); }
            u32x2 o; o.x = pk_fp8x4(f[0] * 16.f, f[1] * 16.f, f[2] * 16.f, f[3] * 16.f); o.y = pk_fp8x4(f[4] * 16.f, f[5] * 16.f, f[6] * 16.f, f[7] * 16.f);
            *(u32x2*)((unsigned char*)hcat + tok * (LDH * 2) + 2048 + 512 + j * 64 + c * 8) = o;
        }
    }
    xcd_barrier(xbar, wave);

    for (int rep_ = 0; rep_ < 1 + ((REPMASK >> 4) & 1); ++rep_) {
        u32x2* tbase = (u32x2*)out + (size_t)bx * (2 * 32 * 512);
        pg8::Gemm g{hcat, W3, LDH, 2176}; pg8::Sched<6> S{TT / 256, 4, G, bx, 0}; pg8::EpiGate6 E{tbase, merged};
        pg8::gemm_phase<pg8::EpiGate6, pg8::Sched<6>, true, true, true>(lds, g, S, E, wave);
    }
    xcd_barrier(xbar, wave);

    for (int rep_ = 0; rep_ < 1 + ((REPMASK >> 5) & 1); ++rep_) {
        int nt8 = 8; asm volatile("" : "+s"(nt8));
        pg8::Gemm g{merged, Wout, 512, 512}; pg8::Sched<1> S{TT / 256, 4, G, bx, nt8}; pg8::EpiOut E{x_p, x_s, out, x1b, ssq, 1.0f / 512.0f};
        pg8::gemm_phase<pg8::EpiOut, pg8::Sched<1>, true, true, true>(lds, g, S, E, wave);
    }
    xcd_barrier(xbar, wave);

    for (int rep_ = 0; rep_ < 1 + ((REPMASK >> 6) & 1); ++rep_) {
        pg8::Gemm g{x1b, Wup, 1024, 1024}; pg8::Sched<1> S{TT / 256, 16, G, bx, 16}; pg8::EpiUp E{hid, ssq};
        pg8::gemm_phase<pg8::EpiUp, pg8::Sched<1>, false, true>(lds, g, S, E, wave);
    }
    xcd_barrier(xbar, wave);

    for (int rep_ = 0; rep_ < 1; ++rep_) {
        pg8::Gemm g{hid, Wdn, DFF, DFF}; pg8::Sched<1> S{TT / 256, 4, G, bx, 64}; pg8::EpiDownNorm E{out, x1b, ssq, (unsigned*)(ws + 4096), final_g};
        pg8::gemm_phase<pg8::EpiDownNorm, pg8::Sched<1>, true, true>(lds, g, S, E, wave);
    }
}

extern "C" void kernel_launch(void* const* d_in, const int* in_sizes, int n_in, void* d_out, int out_size, void* d_ws, size_t ws_size, hipStream_t stream) {
    static int grid = 0;
    if (grid == 0) {
        if (n_in != 18 || out_size != TT * DM || ws_size < WS_END) { fprintf(stderr, "kernel_launch: unexpected shapes (n_in %d out %d ws %zu)\n", n_in, out_size, ws_size); grid = -1; return; }
        int dev = 0, cus = 0, per_cu = 0;
        hipGetDevice(&dev);
        hipDeviceGetAttribute(&cus, hipDeviceAttributeMultiprocessorCount, dev);
        hipFuncSetAttribute((const void*)fwd_megakernel, hipFuncAttributeMaxDynamicSharedMemorySize, LDS_BYTES);
        hipOccupancyMaxActiveBlocksPerMultiprocessor(&per_cu, (const void*)fwd_megakernel, 512, LDS_BYTES);
        if (per_cu < 1) { fprintf(stderr, "kernel_launch: occupancy query says %d blocks per CU\n", per_cu); per_cu = 1; }
        grid = cus * per_cu;
        if (grid < 256) { fprintf(stderr, "kernel_launch: needs 256 co-resident workgroups, device offers %d\n", grid); grid = -1; return; }
        grid = 256;
    }
    if (grid < 0) return;
    hipMemsetAsync(d_ws, 0, 65536, stream);
    Args a{};
    for (int i = 0; i < 18; ++i) a.in[i] = (const float*)d_in[i];
    a.out = (float*)d_out; a.ws = (unsigned char*)d_ws;
    void* kargs[] = {&a};
    hipError_t e = hipLaunchCooperativeKernel((const void*)fwd_megakernel, dim3(grid), dim3(512), kargs, LDS_BYTES, stream);
    if (e != hipSuccess) fprintf(stderr, "cooperative launch failed: %s (grid %d)\n", hipGetErrorString(e), grid);
}
```

```cpp
#include <hip/hip_runtime.h>
#include <hip/hip_cooperative_groups.h>
#include <cstdio>
#include <cstdint>
namespace cg = cooperative_groups;

#define LAS __attribute__((address_space(3)))
typedef unsigned short bf16_t;
typedef short bf16x8 __attribute__((ext_vector_type(8)));
typedef short s16x4 __attribute__((ext_vector_type(4)));
typedef short v4i16_t __attribute__((ext_vector_type(4)));
typedef float f32x4 __attribute__((ext_vector_type(4)));
typedef float f32x16 __attribute__((ext_vector_type(16)));
typedef unsigned u32x4 __attribute__((ext_vector_type(4)));
typedef unsigned u32x2 __attribute__((ext_vector_type(2)));
typedef int v8i_t __attribute__((ext_vector_type(8)));

constexpr int DM = 1024, TP = 32 * 2048, TS = 8 * 2048, TT = TP + TS;
constexpr int NB = 40, SEQ = 2048, NMEM = 256, TMEM = NB * NMEM;
constexpr int NQKV = 3584, NIN = 6656, LDH = 2304, LDW3 = 4352, DFF = 4096;
constexpr int HC_OA = 1024, HC_OB = 1536, HC_OM = 1792;
constexpr float EPS = 1e-6f;
constexpr size_t MiB = 1u << 20;
constexpr int NBA = 320, NBB = 192;
constexpr size_t WS_BIASA = 1 * MiB, WS_BIASB = WS_BIASA + 8 * NBA * 4;
constexpr size_t WS_WQKV = 2 * MiB, WS_W3 = 9 * MiB, WS_WMEM = 18 * MiB, WS_WOUT = 20 * MiB, WS_WUP = 22 * MiB, WS_WDN = 30 * MiB;
constexpr size_t WS_MEMN = 38 * MiB, WS_MKV = 58 * MiB, WS_SSQ = 78 * MiB, WS_LSE = 83 * MiB;
constexpr size_t WS_QKV = 88 * MiB, WS_HCAT = 648 * MiB, WS_END = 1008 * MiB;
constexpr size_t WS_X1B = 88 * MiB, WS_MERGED = 248 * MiB, WS_HID = 248 * MiB;
constexpr size_t DO_OG = 0;
constexpr int LDS_BYTES = 163840;

__device__ __forceinline__ int lane_id() { int l; asm volatile("v_mbcnt_lo_u32_b32 %0, -1, 0\n\tv_mbcnt_hi_u32_b32 %0, -1, %0" : "=v"(l)); return l; }
__device__ __forceinline__ unsigned f2bf(float f) { unsigned u = __builtin_bit_cast(unsigned, f); return (u + 0x7fffu + ((u >> 16) & 1u)) >> 16; }
typedef float f32x2_t __attribute__((ext_vector_type(2))); typedef __bf16 bf16x2_t __attribute__((ext_vector_type(2)));
__device__ __forceinline__ unsigned pk2(float lo, float hi) { f32x2_t v = {lo, hi}; bf16x2_t b = __builtin_convertvector(v, bf16x2_t); return __builtin_bit_cast(unsigned, b); }
__device__ __forceinline__ unsigned pk_fp8x4(float a, float b, float c, float d) { int w = 0; w = __builtin_amdgcn_cvt_pk_fp8_f32(a, b, w, false); w = __builtin_amdgcn_cvt_pk_fp8_f32(c, d, w, true); return (unsigned)w; }
__device__ __forceinline__ float bf2f(unsigned short b) { return __builtin_bit_cast(float, (unsigned)b << 16); }
__device__ __forceinline__ float wave_sum(float v) {
#pragma unroll
    for (int o = 1; o < 64; o <<= 1) v += __shfl_xor(v, o);
    return v;
}
__device__ __forceinline__ int t5_bucket(int rel) {
    int n = rel < 0 ? -rel : rel;
    int b = n < 8 ? n : 8 + (n >= 15) + (n >= 27) + (n >= 50) + (n >= 91) + (n >= 166) + (n >= 305) + (n >= 559);
    return b + (rel > 0 ? 16 : 0);
}

namespace pg8 {
constexpr int BM = 256, BK = 64, HALF = 128, HTB = HALF * BK * 2, STAGE_BYTES = 8 * HTB, NXCD = 8, WGM = 8;
__device__ __forceinline__ int lds_byte(int r, int c) { const int st = (r >> 4) * 2 + (c >> 5), rr = r & 15, cc = c & 31, ob = rr * 64 + cc * 2; return st * 1024 + (ob ^ (((ob >> 9) & 1) << 5)); }
__device__ __forceinline__ void stage_rc(int b, int& R, int& C) { const int st = b / 1024, sb = b % 1024, swz = sb ^ (((sb >> 9) & 1) << 5); R = (st >> 1) * 16 + swz / 64; C = (st & 1) * 32 + (swz % 64) / 2; }
__device__ __forceinline__ int perm32(int rho) { const int n = rho >> 4, i = rho & 15; return 8 * (i >> 2) + 4 * n + (i & 3); }

struct Unit { int pm, pn, aoff, boff, nt, mode; };
struct Gemm { const bf16_t* A; const bf16_t* Bt; int lda, ldb; };

__device__ __forceinline__ void tile_of(int L, int nM, int nN, int& pm, int& pn) {
    const int nwg = nM * nN; int wgid = L;
    { const int q = nwg / NXCD, r = nwg % NXCD, xcd = wgid % NXCD, off = wgid / NXCD; wgid = (xcd < r ? xcd * (q + 1) : r * (q + 1) + (xcd - r) * q) + off; }
    const int nig = WGM * nN, gid = wgid / nig, fm = gid * WGM, gsz = (nM - fm) < WGM ? (nM - fm) : WGM;
    pm = fm + ((wgid % nig) % gsz); pn = (wgid % nig) / gsz;
}
template <int NSUB> struct Sched {
    int nM, nN, G, c, nt0;
    __device__ __forceinline__ bool next(int i, Unit& u) const {
        const int ti = (NSUB == 1) ? i : i / NSUB, sub = (NSUB == 1) ? 0 : i - ti * NSUB;
        const long L = (long)ti * G + c; if (L >= (long)nM * nN) return false;
        tile_of((int)L, nM, nN, u.pm, u.pn);
        if (NSUB == 1) { u.aoff = 0; u.boff = 0; u.nt = nt0; u.mode = 0; }
        else {
            const int br = sub >> 1;
            if ((sub & 1) == 0) { u.aoff = 0; u.boff = 512 * br; u.nt = 8; u.mode = 0; }
            else { u.aoff = br == 0 ? 1024 : (br == 1 ? 1280 : 1408); u.boff = 1536 + (br == 0 ? 0 : (br == 1 ? 256 : 384)); u.nt = br == 1 ? 2 : 4; u.mode = br + 1; }
        }
        asm volatile("" : "+s"(u.nt));
        return true;
    }
};

struct SchedQkv {
    int c, nt0;
    __device__ __forceinline__ bool next(int i, Unit& u) const {
        int L;
        if (i < 17) L = i * 256 + c;
        else if (c < 96 && i == 17) L = 17 * 256 + c;
        else if (c < 32 && i == 18) L = 17 * 256 + 96 + c;
        else return false;
        tile_of(L, TT / 256, NQKV / 256, u.pm, u.pn);
        u.aoff = 0; u.boff = 0; u.nt = nt0; u.mode = 0;
        return true;
    }
};

struct EpiStoreBf16 {
    static constexpr bool PERM = true;
    bf16_t* O; int ldc; float sc;
    __device__ __forceinline__ void operator()(const f32x4 (&acc)[2][2][4][2], const Unit& u, int wr, int wc, int fr, int fq) const {
        asm volatile("" : "+v"(fr), "+v"(fq));
        const int row0 = u.pm * BM + wr * 64 + fr, col0 = u.pn * BM + wc * 32 + 8 * fq;
#pragma unroll
        for (int ai = 0; ai < 2; ++ai)
#pragma unroll
            for (int m = 0; m < 4; ++m) { bf16_t* rowp = O + (size_t)(row0 + ai * HALF + m * 16) * ldc + col0;
#pragma unroll
                for (int bj = 0; bj < 2; ++bj) { const f32x4 v0 = acc[ai][bj][m][0] * sc, v1 = acc[ai][bj][m][1] * sc;
                    u32x4 w; w.x = pk2(v0[0], v0[1]); w.y = pk2(v0[2], v0[3]); w.z = pk2(v1[0], v1[1]); w.w = pk2(v1[2], v1[3]);
                    *(u32x4*)(rowp + bj * HALF) = w; } }
    }
};
struct EpiUp {
    static constexpr bool PERM = true;
    bf16_t* O; const float* ssq;
    __device__ __forceinline__ void operator()(const f32x4 (&acc)[2][2][4][2], const Unit& u, int wr, int wc, int fr, int fq) const {
        const int row0 = u.pm * BM + wr * 64 + fr, col0 = u.pn * BM + wc * 32 + 8 * fq;
        f32x4 sp[2][4];
#pragma unroll
        for (int ai = 0; ai < 2; ++ai)
#pragma unroll
            for (int m = 0; m < 4; ++m) sp[ai][m] = *(const f32x4*)(ssq + (size_t)(row0 + ai * HALF + m * 16) * 16 + 4 * fq);
#pragma unroll
        for (int ai = 0; ai < 2; ++ai)
#pragma unroll
            for (int m = 0; m < 4; ++m) { const int row = row0 + ai * HALF + m * 16;
                float t = (sp[ai][m][0] + sp[ai][m][1]) + (sp[ai][m][2] + sp[ai][m][3]); t += __shfl_xor(t, 16); t += __shfl_xor(t, 32);
                const float rs = rsqrtf(t * (1.0f / DM) + EPS);
                bf16_t* rowp = O + (size_t)row * DFF + col0;
#pragma unroll
                for (int bj = 0; bj < 2; ++bj) { f32x4 v0 = acc[ai][bj][m][0] * rs, v1 = acc[ai][bj][m][1] * rs;
#pragma unroll
                    for (int e = 0; e < 4; ++e) { v0[e] = fmaxf(v0[e], 0.f); v0[e] *= v0[e]; v1[e] = fmaxf(v1[e], 0.f); v1[e] *= v1[e]; }
                    u32x4 w; w.x = pk2(v0[0], v0[1]); w.y = pk2(v0[2], v0[3]); w.z = pk2(v1[0], v1[1]); w.w = pk2(v1[2], v1[3]);
                    *(u32x4*)(rowp + bj * HALF) = w; } }
    }
};
__device__ __forceinline__ f32x4 unpk4(u32x2 w) { f32x4 r; r[0] = __builtin_bit_cast(float, w.x << 16); r[1] = __builtin_bit_cast(float, w.x & 0xffff0000u); r[2] = __builtin_bit_cast(float, w.y << 16); r[3] = __builtin_bit_cast(float, w.y & 0xffff0000u); return r; }
__device__ __forceinline__ u32x2 pk4(f32x4 v) { u32x2 w; w.x = pk2(v[0], v[1]); w.y = pk2(v[2], v[3]); return w; }
struct EpiGate {
    static constexpr bool PERM = true;
    u32x2* tg_; u32x2* tm_; bf16_t* O;
    __device__ __forceinline__ void operator()(const f32x4 (&acc)[2][2][4][2], const Unit& u, int wr, int wc, int fr, int fq) const {
        const int mode = u.mode;
        u32x2* tg = tg_; u32x2* tm = tm_;
        asm volatile("" : "+v"(tg), "+v"(tm));
        if (mode == 0) {
#pragma unroll
            for (int ai = 0; ai < 2; ++ai)
#pragma unroll
                for (int bj = 0; bj < 2; ++bj)
#pragma unroll
                    for (int m = 0; m < 4; ++m)
#pragma unroll
                        for (int n = 0; n < 2; ++n) { const int idx = ((ai * 2 + bj) * 4 + m) * 2 + n; f32x4 a = acc[ai][bj][m][n], s;
#pragma unroll
                            for (int e = 0; e < 4; ++e) s[e] = __builtin_amdgcn_rcpf(1.0f + __builtin_amdgcn_exp2f(-1.4426950408889634f * a[e]));
                            tg[idx * 64] = pk4(s); if (n) asm volatile("" ::: "memory"); }
        } else {
            const int row0 = u.pm * BM + wr * 64 + fr, col0 = u.pn * BM + wc * 32 + 8 * fq;
#pragma unroll
            for (int ai = 0; ai < 2; ++ai) {
                u32x2 g[16], t[16];
#pragma unroll
                for (int k = 0; k < 16; ++k) { g[k] = tg[(ai * 16 + k) * 64]; if (mode != 1) t[k] = tm[(ai * 16 + k) * 64]; }
#pragma unroll
                for (int bj = 0; bj < 2; ++bj)
#pragma unroll
                    for (int m = 0; m < 4; ++m) { const int k = (bj * 4 + m) * 2;
                        f32x4 v0 = unpk4(g[k]) * acc[ai][bj][m][0], v1 = unpk4(g[k + 1]) * acc[ai][bj][m][1];
                        if (mode != 1) { v0 += unpk4(t[k]); v1 += unpk4(t[k + 1]); }
                        if (mode != 3) { tm[(ai * 16 + k) * 64] = pk4(v0); tm[(ai * 16 + k + 1) * 64] = pk4(v1); }
                        else { u32x4 w; w.x = pk2(v0[0], v0[1]); w.y = pk2(v0[2], v0[3]); w.z = pk2(v1[0], v1[1]); w.w = pk2(v1[2], v1[3]);
                               *(u32x4*)(O + (size_t)(row0 + ai * HALF + m * 16) * DM + col0 + bj * HALF) = w; } }
                asm volatile("" ::: "memory");
            }
        }
    }
};
template <bool GATE> struct SchedFix {
    int pm, pn;
    __device__ __forceinline__ bool next(int i, Unit& u) const {
        int lim = 3; asm volatile("" : "+s"(lim));
        asm volatile("" : "+s"(i));
        if (i >= lim) return false;
        u.pm = pm; u.pn = pn; u.mode = i;
        if (GATE) { u.aoff = 0; u.boff = i * 524288; u.nt = 8; }
        else { u.aoff = i == 0 ? 1024 : (i == 1 ? 1280 : 1408); u.boff = i == 0 ? 0 : (i == 1 ? 256 : 384); u.nt = i == 1 ? 2 : 4; }
        asm volatile("" : "+s"(u.nt));
        return true;
    }
};
struct EpiGate6 {
    static constexpr bool PERM = true;
    u32x2* tb_; bf16_t* O;
    __device__ __forceinline__ void operator()(const f32x4 (&acc)[2][2][4][2], const Unit& u, int wr, int wc, int fr, int fq) const {
        const int mode = u.mode;
        const int loff = (wr * 4 + wc) * (32 * 64) + fq * 16 + fr;
        u32x2* tg = tb_ + loff; u32x2* tm = tb_ + 32 * 512 + loff;
        asm volatile("" : "+v"(tg), "+v"(tm));
        if (mode == 0) {
#pragma unroll
            for (int ai = 0; ai < 2; ++ai)
#pragma unroll
                for (int bj = 0; bj < 2; ++bj)
#pragma unroll
                    for (int m = 0; m < 4; ++m)
#pragma unroll
                        for (int n = 0; n < 2; ++n) { const int idx = ((ai * 2 + bj) * 4 + m) * 2 + n; f32x4 a = acc[ai][bj][m][n], sg;
#pragma unroll
                            for (int e = 0; e < 4; ++e) sg[e] = __builtin_amdgcn_rcpf(1.0f + __builtin_amdgcn_exp2f((-1.4426950408889634f / 32.0f) * a[e]));
                            tg[idx * 64] = pk4(sg); if (n) asm volatile("" ::: "memory"); }
        } else {
            const int row0 = u.pm * BM + wr * 64 + fr, col0 = u.pn * BM + wc * 32 + 8 * fq;
#pragma unroll
            for (int ai = 0; ai < 2; ++ai) {
                u32x2 g[16], t[16];
#pragma unroll
                for (int k = 0; k < 16; ++k) { g[k] = tg[(ai * 16 + k) * 64]; if (mode != 1) t[k] = tm[(ai * 16 + k) * 64]; }
#pragma unroll
                for (int bj = 0; bj < 2; ++bj)
#pragma unroll
                    for (int m = 0; m < 4; ++m) { const int k = (bj * 4 + m) * 2;
                        f32x4 v0 = unpk4(g[k]) * (acc[ai][bj][m][0] * (1.0f / 512.0f)), v1 = unpk4(g[k + 1]) * (acc[ai][bj][m][1] * (1.0f / 512.0f));
                        if (mode != 1) { v0 += unpk4(t[k]); v1 += unpk4(t[k + 1]); }
                        if (mode != 3) { tm[(ai * 16 + k) * 64] = pk4(v0); tm[(ai * 16 + k + 1) * 64] = pk4(v1); }
                        else { u32x2 w; w.x = pk_fp8x4(v0[0] * 16.f, v0[1] * 16.f, v0[2] * 16.f, v0[3] * 16.f); w.y = pk_fp8x4(v1[0] * 16.f, v1[1] * 16.f, v1[2] * 16.f, v1[3] * 16.f);
                               *(u32x2*)((unsigned char*)O + (size_t)(row0 + ai * HALF + m * 16) * DM + col0 + bj * HALF) = w; } }
                asm volatile("" ::: "memory");
            }
        }
    }
};
struct EpiOut {
    static constexpr bool PERM = false;
    const float* xp; const float* xs; float* out; bf16_t* x1b; float* ssq; float sc;
    __device__ __forceinline__ void operator()(const f32x4 (&acc)[2][2][4][2], const Unit& u, int wr, int wc, int fr, int fq) const {
        const int row0 = u.pm * BM + wr * 64 + fr, col0 = u.pn * BM + wc * 32 + 4 * fq;
#pragma unroll
        for (int ai = 0; ai < 2; ++ai)
#pragma unroll
            for (int m = 0; m < 4; ++m) { const int row = row0 + ai * HALF + m * 16;
                const float* xr = (row < TP ? xp + (size_t)row * DM : xs + (size_t)(row - TP) * DM) + col0;
                bf16_t* brow = x1b + (size_t)row * DM + col0; float ss = 0.f;
#pragma unroll
                for (int bj = 0; bj < 2; ++bj)
#pragma unroll
                    for (int n = 0; n < 2; ++n) { const int co = bj * HALF + n * 16; const f32x4 v = *(const f32x4*)(xr + co) + acc[ai][bj][m][n] * sc;
                        u32x2 w; w.x = pk2(v[0], v[1]); w.y = pk2(v[2], v[3]); *(u32x2*)(brow + co) = w;
                        ss += (v[0] * v[0] + v[1] * v[1]) + (v[2] * v[2] + v[3] * v[3]); }
                ss += __shfl_xor(ss, 16); ss += __shfl_xor(ss, 32);
                if (fq == 0) ssq[(size_t)row * 16 + u.pn * 4 + wc] = ss; }
    }
};
struct EpiDownNorm {
    static constexpr bool PERM = false;
    float* out; const bf16_t* x1b; float* xbuf; unsigned* cnt; const float* gf;
    __device__ __forceinline__ void operator()(f32x4 (&acc)[2][2][4][2], const Unit& u, int wr, int wc, int fr, int fq) const {
        const int row0 = u.pm * BM + wr * 64 + fr, col0 = u.pn * BM + wc * 32 + 4 * fq;
#pragma unroll
        for (int ai = 0; ai < 2; ++ai)
#pragma unroll
            for (int m = 0; m < 4; ++m) { const int row = row0 + ai * HALF + m * 16; const bf16_t* orow = x1b + (size_t)row * DM + col0; float ss = 0.f;
#pragma unroll
                for (int bj = 0; bj < 2; ++bj)
#pragma unroll
                    for (int n = 0; n < 2; ++n) { const f32x4 v = unpk4(*(const u32x2*)(orow + bj * HALF + n * 16)) + acc[ai][bj][m][n]; acc[ai][bj][m][n] = v;
                        ss += (v[0] * v[0] + v[1] * v[1]) + (v[2] * v[2] + v[3] * v[3]); }
                ss += __shfl_xor(ss, 16); ss += __shfl_xor(ss, 32);
                if (fq == 0) __hip_atomic_store(xbuf + (size_t)row * 16 + u.pn * 4 + wc, ss, __ATOMIC_RELAXED, __HIP_MEMORY_SCOPE_AGENT);
                if (m == 3) asm volatile("" ::: "memory"); }
        asm volatile("s_waitcnt vmcnt(0)" ::: "memory");
        unsigned* c = cnt + u.pm * 16;
        if (fr == 0 && fq == 0) __hip_atomic_fetch_add(c, 1u, __ATOMIC_RELAXED, __HIP_MEMORY_SCOPE_AGENT);
        while (__hip_atomic_load(c, __ATOMIC_RELAXED, __HIP_MEMORY_SCOPE_AGENT) < 32u) __builtin_amdgcn_s_sleep(1);
        asm volatile("" ::: "memory");
#pragma unroll
        for (int ai = 0; ai < 2; ++ai)
#pragma unroll
            for (int m = 0; m < 4; ++m) { const int row = row0 + ai * HALF + m * 16; float* orow = out + (size_t)row * DM + col0;
                const unsigned long long* sp = (const unsigned long long*)(xbuf + (size_t)row * 16 + 4 * fq);
                const unsigned long long qa = __hip_atomic_load(sp, __ATOMIC_RELAXED, __HIP_MEMORY_SCOPE_AGENT), qb = __hip_atomic_load(sp + 1, __ATOMIC_RELAXED, __HIP_MEMORY_SCOPE_AGENT);
                float t = (__uint_as_float((unsigned)qa) + __uint_as_float((unsigned)(qa >> 32))) + (__uint_as_float((unsigned)qb) + __uint_as_float((unsigned)(qb >> 32)));
                t += __shfl_xor(t, 16); t += __shfl_xor(t, 32);
                const float rs = rsqrtf(t * (1.0f / DM) + EPS);
#pragma unroll
                for (int bj = 0; bj < 2; ++bj)
#pragma unroll
                    for (int n = 0; n < 2; ++n) { const int co = bj * HALF + n * 16; const f32x4 g = *(const f32x4*)(gf + col0 + co); *(f32x4*)(orow + co) = acc[ai][bj][m][n] * rs * g; } }
    }
};

template <class Epi, class SchedT, bool ALIGN_EPI, bool SP2, bool FP8 = false>
__device__ __forceinline__ void gemm_phase(LAS unsigned char* lds, const Gemm g, const SchedT& S, const Epi& E, const int wid) {
    const int lane = lane_id(), tid = wid * 64 + lane, wr = wid >> 2, wc = wid & 3, fr = lane & 15, fq = lane >> 4;
    unsigned voffA[2], voffB[2];
#pragma unroll
    for (int i = 0; i < 2; ++i) { int R, C; stage_rc(tid * 16 + i * 8192, R, C); const int Rb = Epi::PERM ? ((R & ~31) + perm32(R & 31)) : R;
        voffA[i] = (unsigned)(R * g.lda + C) * 2u; voffB[i] = (unsigned)(Rb * g.ldb + C) * 2u; }
    const size_t kstep = (size_t)(BK * 2);
    const size_t hstepA = (size_t)HALF * g.lda * 2, hstepB = (size_t)HALF * g.ldb * 2;
    const size_t tstepA = 2 * hstepA, tstepB = 2 * hstepB;
    const unsigned ldsw = (unsigned)wid * 1024u;
    const int aoff = FP8 ? lds_byte(wr * 64 + fr, fq * 16) : lds_byte(wr * 64 + fr, fq * 8), boff = FP8 ? lds_byte(wc * 32 + fr, fq * 16) : lds_byte(wc * 32 + fr, fq * 8);
    const int aoff1 = FP8 ? lds_byte(wr * 64 + fr, fq * 16 + 8) : aoff + 1024, boff1 = FP8 ? lds_byte(wc * 32 + fr, fq * 16 + 8) : boff + 1024;
#define PG8_SA(b, h) (((b) * 2 + (h)) * HTB)
#define PG8_SB(b, h) ((4 + (b) * 2 + (h)) * HTB)
#define PG8_STAGE(bufoff, gbase, voff) do { _Pragma("unroll") for (int _i = 0; _i < 2; ++_i) { unsigned vo_ = (voff)[_i]; asm volatile("" : "+v"(vo_));     \
        __builtin_amdgcn_global_load_lds((const unsigned*)((const char*)(gbase) + vo_), (LAS unsigned*)(lds + (bufoff) + ldsw + _i * 8192), 16, 0, 0); } } while (0)
#define PG8_CAT(lo, hi) __builtin_bit_cast(v8i_t, __builtin_shufflevector(lo, hi, 0, 1, 2, 3, 4, 5, 6, 7, 8, 9, 10, 11, 12, 13, 14, 15))
#define PG8_LD8(base, off0, off1, g) PG8_CAT(*(const LAS bf16x8*)(lds + (base) + (off0) + (g) * 2048), *(const LAS bf16x8*)(lds + (base) + (off0) + 16 + (g) * 2048))
#define PG8_LDA(dst, b, h) do { if constexpr (FP8) { _Pragma("unroll") for (int m = 0; m < 4; ++m) dst##8[m] = PG8_LD8(PG8_SA(b, h), aoff, aoff1, m); } \
        else { _Pragma("unroll") for (int m = 0; m < 4; ++m) _Pragma("unroll") for (int k = 0; k < 2; ++k) dst[m][k] = *(const LAS bf16x8*)(lds + PG8_SA(b, h) + (k ? aoff1 : aoff) + m * 2048); } } while (0)
#define PG8_LDB(dst, b, h) do { if constexpr (FP8) { dst##8[0] = PG8_LD8(PG8_SB(b, h), boff, boff1, 0); dst##8[1] = PG8_LD8(PG8_SB(b, h), boff, boff1, 1); } \
        else { _Pragma("unroll") for (int n = 0; n < 2; ++n) _Pragma("unroll") for (int k = 0; k < 2; ++k) dst[n][k] = *(const LAS bf16x8*)(lds + PG8_SB(b, h) + (k ? boff1 : boff) + n * 2048); } } while (0)
#define PG8_F8(a_, b_, c_) __builtin_amdgcn_mfma_scale_f32_16x16x128_f8f6f4(a_, b_, c_, 0, 0, 0, 127, 0, 127)
#define PG8_MMA2(ai, b, h) do { __builtin_amdgcn_s_setprio(1); \
        _Pragma("unroll") for (int mm = 0; mm < 2; ++mm) _Pragma("unroll") for (int n = 0; n < 2; ++n) { acc[ai][0][mm][n] = PG8_F8(B08[n], At8[mm], acc[ai][0][mm][n]); acc[ai][1][mm][n] = PG8_F8(B18[n], At8[mm], acc[ai][1][mm][n]); } \
        At8[0] = PG8_LD8(PG8_SA(b, h), aoff, aoff1, 2); At8[1] = PG8_LD8(PG8_SA(b, h), aoff, aoff1, 3); PG8_WAIT_L(0); \
        _Pragma("unroll") for (int mm = 0; mm < 2; ++mm) _Pragma("unroll") for (int n = 0; n < 2; ++n) { acc[ai][0][2 + mm][n] = PG8_F8(B08[n], At8[mm], acc[ai][0][2 + mm][n]); acc[ai][1][2 + mm][n] = PG8_F8(B18[n], At8[mm], acc[ai][1][2 + mm][n]); } \
        PG8_WAIT_L(0); __builtin_amdgcn_s_setprio(0); } while (0)
#define PG8_MMA2S(ai, b, h, STG) do { __builtin_amdgcn_s_setprio(1); \
        _Pragma("unroll") for (int mm = 0; mm < 2; ++mm) _Pragma("unroll") for (int n = 0; n < 2; ++n) { acc[ai][0][mm][n] = PG8_F8(B08[n], At8[mm], acc[ai][0][mm][n]); acc[ai][1][mm][n] = PG8_F8(B18[n], At8[mm], acc[ai][1][mm][n]); } \
        At8[0] = PG8_LD8(PG8_SA(b, h), aoff, aoff1, 2); At8[1] = PG8_LD8(PG8_SA(b, h), aoff, aoff1, 3); PG8_WAIT_L(0); PG8_SCHED; STG; \
        _Pragma("unroll") for (int mm = 0; mm < 2; ++mm) _Pragma("unroll") for (int n = 0; n < 2; ++n) { acc[ai][0][2 + mm][n] = PG8_F8(B08[n], At8[mm], acc[ai][0][2 + mm][n]); acc[ai][1][2 + mm][n] = PG8_F8(B18[n], At8[mm], acc[ai][1][2 + mm][n]); } \
        __builtin_amdgcn_s_setprio(0); } while (0)
#define PG8_MMA(ai, bj, At, Bt) do { __builtin_amdgcn_s_setprio(1); _Pragma("unroll") for (int m = 0; m < 4; ++m) _Pragma("unroll") for (int n = 0; n < 2; ++n) _Pragma("unroll") for (int k = 0; k < 2; ++k) \
        acc[ai][bj][m][n] = __builtin_amdgcn_mfma_f32_16x16x32_bf16(Bt[n][k], At[m][k], acc[ai][bj][m][n], 0, 0, 0); __builtin_amdgcn_s_setprio(0); } while (0)
#define PG8_MMAP(ai, b, h) do { if constexpr (FP8) { __builtin_amdgcn_s_setprio(1); \
        _Pragma("unroll") for (int m = 0; m < 4; ++m) _Pragma("unroll") for (int n = 0; n < 2; ++n) { acc[ai][0][m][n] = PG8_F8(B08[n], At8[m], acc[ai][0][m][n]); acc[ai][1][m][n] = PG8_F8(B18[n], At8[m], acc[ai][1][m][n]); } \
        __builtin_amdgcn_s_setprio(0); } else { PG8_MMA(ai, 0, At, B0); PG8_MMA(ai, 1, At, B1); } } while (0)
#define PG8_WAIT_V(n) asm volatile("s_waitcnt vmcnt(" #n ")" ::: "memory")
#define PG8_WAIT_L(n) asm volatile("s_waitcnt lgkmcnt(" #n ")" ::: "memory")
#define PG8_BAR __builtin_amdgcn_s_barrier()
#define PG8_SCHED __builtin_amdgcn_sched_barrier(0)
    Unit cur, nxt; int ui = 0;
    if (!S.next(0, cur)) return;
    f32x4 acc[2][2][4][2];
#pragma unroll
    for (int a = 0; a < 2; ++a)
#pragma unroll
        for (int b = 0; b < 2; ++b)
#pragma unroll
            for (int m = 0; m < 4; ++m)
#pragma unroll
                for (int n = 0; n < 2; ++n) acc[a][b][m][n] = (f32x4){0.f, 0.f, 0.f, 0.f};
    bf16x8 At[4][2], B0[2][2], B1[2][2];
    v8i_t At8[4], B08[2], B18[2];
    const char* cA = (const char*)g.A + (size_t)cur.pm * tstepA + (size_t)cur.aoff * 2; const char* cB = (const char*)g.Bt + (size_t)cur.pn * tstepB + (size_t)cur.boff * 2;
    if constexpr (SP2) {
        PG8_STAGE(PG8_SB(0, 0), cB, voffB); PG8_STAGE(PG8_SB(0, 1), cB + hstepB, voffB); PG8_STAGE(PG8_SA(0, 0), cA, voffA); PG8_STAGE(PG8_SA(0, 1), cA + hstepA, voffA);
        if (wr == 1) PG8_BAR;
        PG8_WAIT_V(2); PG8_BAR;
        PG8_STAGE(PG8_SB(1, 0), cB + kstep, voffB); PG8_STAGE(PG8_SA(1, 0), cA + kstep, voffA); PG8_STAGE(PG8_SB(1, 1), cB + hstepB + kstep, voffB);
        PG8_WAIT_V(6); PG8_BAR;
    } else {
        PG8_STAGE(PG8_SB(0, 0), cB, voffB); PG8_STAGE(PG8_SA(0, 0), cA, voffA); PG8_STAGE(PG8_SB(0, 1), cB + hstepB, voffB); PG8_STAGE(PG8_SA(0, 1), cA + hstepA, voffA);
        if (wr == 1) PG8_BAR;
        PG8_WAIT_V(4); PG8_BAR;
        PG8_STAGE(PG8_SB(1, 0), cB + kstep, voffB); PG8_STAGE(PG8_SA(1, 0), cA + kstep, voffA); PG8_STAGE(PG8_SB(1, 1), cB + hstepB + kstep, voffB);
        PG8_WAIT_V(6); PG8_BAR;
    }
    for (;;) {
        const bool has_next = S.next(ui + 1, nxt);
        const char* nA = has_next ? (const char*)g.A + (size_t)nxt.pm * tstepA + (size_t)nxt.aoff * 2 : cA; const char* nB = has_next ? (const char*)g.Bt + (size_t)nxt.pn * tstepB + (size_t)nxt.boff * 2 : cB;
        const int nt = cur.nt;
        for (int t = 0; t < nt; t += 2) {
            const bool last = (t == nt - 2);
            const char* a1 = cA + (size_t)(t + 1) * kstep;
            const char* a2 = last ? nA : cA + (size_t)(t + 2) * kstep; const char* b2 = last ? nB : cB + (size_t)(t + 2) * kstep;
            const char* a3 = a2 + kstep; const char* b3 = b2 + kstep;
            if constexpr (SP2) {
#define PG8_S1 PG8_STAGE(PG8_SA(1, 1), a1 + hstepA, voffA)
#define PG8_S2 do { PG8_STAGE(PG8_SB(0, 0), b2, voffB); PG8_STAGE(PG8_SB(0, 1), b2 + hstepB, voffB); PG8_STAGE(PG8_SA(0, 0), a2, voffA); } while (0)
#define PG8_S3 PG8_STAGE(PG8_SA(0, 1), a2 + hstepA, voffA)
#define PG8_S4 do { PG8_STAGE(PG8_SB(1, 0), b3, voffB); PG8_STAGE(PG8_SB(1, 1), b3 + hstepB, voffB); PG8_STAGE(PG8_SA(1, 0), a3, voffA); } while (0)
            PG8_LDB(B0, 0, 0); PG8_LDB(B1, 0, 1); PG8_SCHED; PG8_LDA(At, 0, 0); PG8_S1;
            PG8_WAIT_V(8); PG8_WAIT_L(0); PG8_BAR; PG8_MMAP(0, 0, 0); PG8_BAR; PG8_SCHED;
            PG8_LDA(At, 0, 1); PG8_S2;
            PG8_WAIT_V(8); PG8_WAIT_L(0); PG8_BAR; PG8_MMAP(1, 0, 1); PG8_BAR; PG8_SCHED;
            PG8_LDB(B0, 1, 0); PG8_LDB(B1, 1, 1); PG8_SCHED; PG8_LDA(At, 1, 0); PG8_S3;
            PG8_WAIT_V(8); PG8_WAIT_L(0); PG8_BAR; PG8_MMAP(0, 1, 0); PG8_BAR; PG8_SCHED;
            PG8_LDA(At, 1, 1); PG8_S4;
            PG8_WAIT_V(8); PG8_WAIT_L(0); PG8_BAR; PG8_MMAP(1, 1, 1); PG8_BAR; PG8_SCHED;
            } else {
            PG8_LDB(B0, 0, 0); PG8_SCHED; PG8_LDA(At, 0, 0); PG8_STAGE(PG8_SA(1, 1), a1 + hstepA, voffA);
            PG8_WAIT_L(8); PG8_BAR; PG8_WAIT_L(0); PG8_MMA(0, 0, At, B0); PG8_BAR; PG8_SCHED;
            PG8_LDB(B1, 0, 1); PG8_STAGE(PG8_SB(0, 0), b2, voffB);
            PG8_BAR; PG8_WAIT_L(0); PG8_MMA(0, 1, At, B1); PG8_BAR;
            PG8_LDA(At, 0, 1); PG8_STAGE(PG8_SA(0, 0), a2, voffA);
            PG8_BAR; PG8_WAIT_L(0); PG8_MMA(1, 0, At, B0); PG8_BAR; PG8_SCHED;
            PG8_STAGE(PG8_SB(0, 1), b2 + hstepB, voffB);
            PG8_WAIT_V(6); PG8_BAR; PG8_MMA(1, 1, At, B1); PG8_BAR;
            PG8_LDB(B0, 1, 0); PG8_SCHED; PG8_LDA(At, 1, 0); PG8_STAGE(PG8_SA(0, 1), a2 + hstepA, voffA);
            PG8_WAIT_L(8); PG8_BAR; PG8_WAIT_L(0); PG8_MMA(0, 0, At, B0); PG8_BAR; PG8_SCHED;
            PG8_LDB(B1, 1, 1); PG8_STAGE(PG8_SB(1, 0), b3, voffB);
            PG8_BAR; PG8_WAIT_L(0); PG8_MMA(0, 1, At, B1); PG8_BAR;
            PG8_LDA(At, 1, 1); PG8_STAGE(PG8_SA(1, 0), a3, voffA);
            PG8_BAR; PG8_WAIT_L(0); PG8_MMA(1, 0, At, B0); PG8_BAR; PG8_SCHED;
            PG8_STAGE(PG8_SB(1, 1), b3 + hstepB, voffB);
            PG8_WAIT_V(6); PG8_BAR; PG8_MMA(1, 1, At, B1); PG8_BAR;
            }
        }
        if constexpr (ALIGN_EPI) { if (wr == 0) PG8_BAR; }
        { const int l2_ = lane_id(); E(acc, cur, wr, wc, l2_ & 15, l2_ >> 4); }
        if (!has_next) break;
#pragma unroll
        for (int a = 0; a < 2; ++a)
#pragma unroll
            for (int b = 0; b < 2; ++b)
#pragma unroll
                for (int m = 0; m < 4; ++m)
#pragma unroll
                    for (int n = 0; n < 2; ++n) acc[a][b][m][n] = (f32x4){0.f, 0.f, 0.f, 0.f};
        cur = nxt; cA = nA; cB = nB; ++ui;
        if constexpr (ALIGN_EPI) { if (wr == 1) PG8_BAR; }
    }
    PG8_WAIT_V(0);
    if constexpr (!ALIGN_EPI) { if (wr == 0) PG8_BAR; }
    PG8_BAR;
#undef PG8_SA
#undef PG8_SB
#undef PG8_STAGE
#undef PG8_LDA
#undef PG8_CAT
#undef PG8_LD8
#undef PG8_F8
#undef PG8_MMA2
#undef PG8_MMA2S
#undef PG8_S1
#undef PG8_S2
#undef PG8_S3
#undef PG8_S4
#undef PG8_MMAP
#undef PG8_LDB
#undef PG8_MMA
#undef PG8_WAIT_V
#undef PG8_WAIT_L
#undef PG8_BAR
#undef PG8_SCHED
}
}

#define MFMA32(a, b, c) __builtin_amdgcn_mfma_f32_32x32x16_bf16((a), (b), (c), 0, 0, 0)
__device__ __forceinline__ s16x4 vtr(LAS const char* p) { return __builtin_bit_cast(s16x4, __builtin_amdgcn_ds_read_tr16_b64_v4i16((LAS v4i16_t*)p)); }
__device__ __forceinline__ int crow(int r, int hi) { return (r & 3) + 8 * (r >> 2) + 4 * hi; }
constexpr int ALDS_K = 0, ALDS_V = 65536, ALDS_BIAS = 131072;

struct UDesc {
    int type;
    const bf16_t* qp; const bf16_t* kp; const bf16_t* vp;
    long tstride, sstride;
    int nh, Ld, q0, QB, HALF, nsub;
    const float* bias;
    const float* sink;
    bf16_t* op; long o_tstride, o_sstride;
    float* lsep; long l_tstride, l_sstride;
};
__device__ __forceinline__ void stage_issue(const UDesc& d, const int wave, u32x4 (&kr)[8], u32x4 (&vr)[8], float (&bv)[3]) {
    const int tid = wave * 64 + lane_id();
    if (d.type == 0) {
        const int c = tid & 15;
#pragma unroll
        for (int j = 0; j < 8; ++j) { const size_t off = (size_t)(j * 32 + (tid >> 4)) * 1024 + c * 8; kr[j] = *(const u32x4*)(d.kp + off); vr[j] = *(const u32x4*)(d.vp + off); }
    } else {
        const int c = tid & 7, NK = d.QB + 2 * d.HALF, nb = d.nh * (2 * d.HALF + 64);
#pragma unroll
        for (int j = 0; j < 8; ++j) { const int r = j * 64 + (tid >> 3); int sub = r / NK; const int i = r - sub * NK; sub = sub < d.nsub ? sub : d.nsub - 1;
            int idx = d.q0 - d.HALF + i; idx = idx < 0 ? 0 : (idx >= d.Ld ? d.Ld - 1 : idx);
            const size_t off = (size_t)sub * d.sstride + (size_t)idx * d.tstride + c * 8;
            kr[j] = *(const u32x4*)(d.kp + off); vr[j] = *(const u32x4*)(d.vp + off); }
#pragma unroll
        for (int t = 0; t < 3; ++t) { const int i = tid + 512 * t; bv[t] = d.bias[i < nb ? i : nb - 1]; }
    }
}
__device__ __forceinline__ void stage_commit(const UDesc& d, LAS char* lds, const int wave, const u32x4 (&kr)[8], const u32x4 (&vr)[8], const float (&bv)[3]) {
    const int tid = wave * 64 + lane_id();
    LAS char* Kl = lds + ALDS_K; LAS char* Vl = lds + ALDS_V;
    if (d.type == 0) {
        const int c = tid & 15;
#pragma unroll
        for (int j = 0; j < 8; ++j) { const int r = j * 32 + (tid >> 4);
            *(LAS u32x4*)(Kl + r * 256 + ((c ^ (r & 15)) << 4)) = kr[j];
            *(LAS u32x4*)(Vl + (c >> 2) * 16384 + r * 64 + (c & 3) * 16) = vr[j]; }
    } else {
        const int c = tid & 7, nb = d.nh * (2 * d.HALF + 64);
#pragma unroll
        for (int j = 0; j < 8; ++j) { const int r = j * 64 + (tid >> 3);
            *(LAS u32x4*)(Kl + r * 128 + ((c ^ ((r >> 1) & 7)) << 4)) = kr[j];
            *(LAS u32x4*)(Vl + (c >> 2) * 32768 + r * 64 + (c & 3) * 16) = vr[j]; }
        LAS float* Bl = (LAS float*)(lds + ALDS_BIAS);
#pragma unroll
        for (int t = 0; t < 3; ++t) { const int i = tid + 512 * t; if (i < nb) Bl[i] = bv[t]; }
        if (tid < 64) ((LAS float*)(lds + ALDS_BIAS + 6144))[tid] = -1e30f;
    }
}

__device__ __forceinline__ unsigned cvtpk(float lo, float hi) { f32x2_t v = {lo, hi}; bf16x2_t b = __builtin_convertvector(v, bf16x2_t); return __builtin_bit_cast(unsigned, b); }
__device__ __forceinline__ float xhalf_max(float v) { auto rr = __builtin_amdgcn_permlane32_swap(__float_as_uint(v), __float_as_uint(v), false, false); return fmaxf(__uint_as_float(rr[0]), __uint_as_float(rr[1])); }
__device__ __forceinline__ float xhalf_sum(float v) { auto rr = __builtin_amdgcn_permlane32_swap(__float_as_uint(v), __float_as_uint(v), false, false); return __uint_as_float(rr[0]) + __uint_as_float(rr[1]); }
__device__ __forceinline__ float max16(const f32x16& p) {
    float a = fmaxf(fmaxf(p[0], p[1]), p[2]), b = fmaxf(fmaxf(p[3], p[4]), p[5]);
    a = fmaxf(fmaxf(a, p[6]), p[7]); b = fmaxf(fmaxf(b, p[8]), p[9]); a = fmaxf(fmaxf(a, p[10]), p[11]); b = fmaxf(fmaxf(b, p[12]), p[13]);
    a = fmaxf(fmaxf(a, p[14]), p[15]); return fmaxf(a, b);
}
constexpr int ALDS_NEG = ALDS_BIAS + 6144;
template <int NKT, int DH, bool HASB>
__device__ __forceinline__ void attn_scores(LAS const char* Kl, const int krow0, LAS const float* bl, LAS const float* negl, const int kt_lo, const int kt_hi,
                                            const bf16x8 (&qf)[DH], const int h, f32x16 (&S)[NKT]) {
    const int sw = DH == 4 ? ((krow0 >> 1) & 7) : (krow0 & 15);
    LAS const char* kbase[DH];
#pragma unroll
    for (int d0 = 0; d0 < DH; ++d0) kbase[d0] = Kl + krow0 * (DH * 32) + (((2 * d0 + h) ^ sw) << 4);
    constexpr int KTS = 32 * DH * 32;
    constexpr bool PF = (DH == 4);
    bf16x8 kf[DH], kfn[DH];
#pragma unroll
    for (int d0 = 0; d0 < DH; ++d0) kf[d0] = *(LAS const bf16x8*)(kbase[d0]);
    if (HASB) { LAS const float* bt = (0 >= kt_lo && 0 < kt_hi) ? bl : negl;
#pragma unroll
        for (int i = 0; i < 16; ++i) S[0][i] = bt[(i & 3) + 8 * (i >> 2)]; }
    else {
#pragma unroll
        for (int i = 0; i < 16; ++i) S[0][i] = 0.f; }
#pragma unroll
    for (int kt = 0; kt < NKT; ++kt) {
        if (!PF && kt > 0) {
#pragma unroll
            for (int d0 = 0; d0 < DH; ++d0) kf[d0] = *(LAS const bf16x8*)(kbase[d0] + kt * KTS);
        }
        if (!PF) __builtin_amdgcn_sched_barrier(0);
        if (kt + 1 < NKT) {
            if (PF) {
#pragma unroll
                for (int d0 = 0; d0 < DH; ++d0) kfn[d0] = *(LAS const bf16x8*)(kbase[d0] + (kt + 1) * KTS);
            }
            if (HASB) { LAS const float* bt = (kt + 1 >= kt_lo && kt + 1 < kt_hi) ? bl + 32 * (kt + 1) : negl;
#pragma unroll
                for (int i = 0; i < 16; ++i) S[kt + 1][i] = bt[(i & 3) + 8 * (i >> 2)]; }
            else {
#pragma unroll
                for (int i = 0; i < 16; ++i) S[kt + 1][i] = 0.f; }
        }
#pragma unroll
        for (int d0 = 0; d0 < DH; ++d0) S[kt] = MFMA32(kf[d0], qf[d0], S[kt]);
        if (PF && kt + 1 < NKT) {
#pragma unroll
            for (int d0 = 0; d0 < DH; ++d0) kf[d0] = kfn[d0];
        }
        asm volatile("" : "+v"(S[kt]) :: "memory");
        __builtin_amdgcn_sched_barrier(0);
    }
}
template <int NKT, int DH>
__device__ __forceinline__ void attn_finish(f32x16 (&S)[NKT], LAS const char* Vl, const int vrow0, const int vplane, const float sinkv, const bool has_sink, const int lane,
                                            f32x16 (&o)[DH / 2], float& scale_out, float& lse_out) {
    const int h = lane >> 5;
    float mx = max16(S[0]);
#pragma unroll
    for (int kt = 1; kt < NKT; ++kt) mx = fmaxf(mx, max16(S[kt]));
    mx = xhalf_max(mx);
    if (has_sink) mx = fmaxf(mx, sinkv);
    float l = 0.f;
    u32x4 pw[NKT][2];
#pragma unroll
    for (int kt = 0; kt < NKT; ++kt) {
        float ls = 0.f;
#pragma unroll
        for (int i = 0; i < 16; ++i) { S[kt][i] = __builtin_amdgcn_exp2f(S[kt][i] - mx); ls += S[kt][i]; }
        l += ls;
#pragma unroll
        for (int q = 0; q < 4; ++q) { pw[kt][0][q] = cvtpk(S[kt][2 * q], S[kt][2 * q + 1]); pw[kt][1][q] = cvtpk(S[kt][8 + 2 * q], S[kt][9 + 2 * q]); }
        asm volatile("" : "+v"(pw[kt][0]), "+v"(pw[kt][1]), "+v"(l));
        __builtin_amdgcn_sched_barrier(0);
    }
#pragma unroll
    for (int db = 0; db < DH / 2; ++db)
#pragma unroll
        for (int i = 0; i < 16; ++i) o[db][i] = 0.f;
    LAS const char* vb = Vl + (vrow0 + 4 * h + ((lane & 15) >> 2)) * 64 + ((lane >> 4) & 1) * 32 + (lane & 3) * 8;
    s16x4 va[DH / 2][4], vn[DH / 2][4];
#pragma unroll
    for (int db = 0; db < DH / 2; ++db)
#pragma unroll
        for (int q = 0; q < 4; ++q) va[db][q] = vtr(vb + db * vplane + q * 512);
    __builtin_amdgcn_sched_barrier(0);
#pragma unroll
    for (int kt = 0; kt < NKT; ++kt) {
        if (kt + 1 < NKT) {
#pragma unroll
            for (int db = 0; db < DH / 2; ++db)
#pragma unroll
                for (int q = 0; q < 4; ++q) vn[db][q] = vtr(vb + (kt + 1) * 2048 + db * vplane + q * 512);
        }
        const bf16x8 pb0 = __builtin_bit_cast(bf16x8, pw[kt][0]), pb1 = __builtin_bit_cast(bf16x8, pw[kt][1]);
#pragma unroll
        for (int db = 0; db < DH / 2; ++db) {
            o[db] = MFMA32(__builtin_shufflevector(va[db][0], va[db][1], 0, 1, 2, 3, 4, 5, 6, 7), pb0, o[db]);
            o[db] = MFMA32(__builtin_shufflevector(va[db][2], va[db][3], 0, 1, 2, 3, 4, 5, 6, 7), pb1, o[db]);
        }
#pragma unroll
        for (int db = 0; db < DH / 2; ++db)
#pragma unroll
            for (int q = 0; q < 4; ++q) va[db][q] = vn[db][q];
#pragma unroll
        for (int db = 0; db < DH / 2; ++db) asm volatile("" : "+v"(o[db]) :: "memory");
        __builtin_amdgcn_sched_barrier(0);
    }
    l = xhalf_sum(l);
    if (has_sink) l += __builtin_amdgcn_exp2f(sinkv - mx);
    scale_out = 1.0f / l; lse_out = mx + __builtin_amdgcn_logf(l);
}
constexpr int ALDS_OST = 139264;
template <int NDB>
__device__ __forceinline__ void store_o_tile(LAS char* stg, const f32x16 (&o)[NDB], const float scale, bf16_t* tile_base, const long row_stride, const int lane) {
    const int ql = lane & 31, h = lane >> 5;
    LAS char* wp = stg + ql * 64 + 8 * h; const int wsw = (ql >> 1) & 3;
    const int r0 = lane >> 2, c = lane & 3;
#pragma unroll
    for (int db = 0; db < NDB; ++db) {
#pragma unroll
        for (int g4 = 0; g4 < 4; ++g4) { u32x2 w; w.x = cvtpk(o[db][4 * g4] * scale, o[db][4 * g4 + 1] * scale); w.y = cvtpk(o[db][4 * g4 + 2] * scale, o[db][4 * g4 + 3] * scale);
            *(LAS u32x2*)(wp + ((g4 ^ wsw) << 4)) = w; }
#pragma unroll
        for (int t = 0; t < 2; ++t) { const int r = t * 16 + r0; const u32x4 v = *(LAS const u32x4*)(stg + r * 64 + ((c ^ ((r >> 1) & 3)) << 4));
            *(u32x4*)(tile_base + (size_t)r * row_stride + db * 32 + c * 8) = v; }
    }
}
template <int NDB>
__device__ __forceinline__ void store_o_tile8(LAS char* stg, const f32x16 (&o)[NDB], const float scale, unsigned char* tile_base8, const long row_stride, const int lane) {
    const int ql = lane & 31, h = lane >> 5;
    LAS char* wp = stg + ql * 32 + 4 * h;
    const int r = lane >> 1, hf = lane & 1;
    const float s16 = scale * 16.0f;
#pragma unroll
    for (int db = 0; db < NDB; ++db) {
#pragma unroll
        for (int g4 = 0; g4 < 4; ++g4) *(LAS unsigned*)(wp + 8 * g4) = pk_fp8x4(o[db][4 * g4] * s16, o[db][4 * g4 + 1] * s16, o[db][4 * g4 + 2] * s16, o[db][4 * g4 + 3] * s16);
        const u32x4 v = *(LAS const u32x4*)(stg + r * 32 + hf * 16);
        *(u32x4*)(tile_base8 + (size_t)r * row_stride + db * 32 + hf * 16) = v;
    }
}
__device__ __forceinline__ const bf16_t* band_qrow(const UDesc& d, int wt, int ql, int h) {
    const int nq32 = d.QB >> 5; const int sub = wt / (d.nh * nq32), rem = wt - sub * (d.nh * nq32), hh = rem / nq32, qs = (rem - hh * nq32) * 32;
    return d.qp + (size_t)sub * d.sstride + (size_t)(d.q0 + qs + ql) * d.tstride + hh * 64 + 8 * h;
}
template <int NKT, bool OUT8>
__device__ __forceinline__ void band_compute(LAS char* lds, const UDesc& d, const int wave, bf16x8 (&qf)[4]) {
    const int lane = lane_id(), ql = lane & 31, h = lane >> 5;
    const int NK = d.QB + 2 * d.HALF, nbx = 2 * d.HALF + 64;
    LAS char* Kl = lds + ALDS_K; LAS char* Vl = lds + ALDS_V; LAS float* Bl = (LAS float*)(lds + ALDS_BIAS); LAS const float* negl = (LAS const float*)(lds + ALDS_NEG);
    const int nq32 = d.QB >> 5, ntiles = d.nsub * d.nh * nq32, nkt = (32 + 2 * d.HALF) >> 5;
    for (int wt = wave; wt < ntiles; wt += 8) {
        const int sub = wt / (d.nh * nq32), rem = wt - sub * (d.nh * nq32), hh = rem / nq32, qs = (rem - hh * nq32) * 32;
        const int qidx = d.q0 + qs + ql;
        LAS const float* bl = Bl + hh * nbx + 32 - ql + 4 * h;
        const int rbase = sub * NK;
        const int k0 = d.q0 - d.HALF + qs;
        int kt_lo = k0 < 0 ? (-k0) >> 5 : 0, kt_hi = (d.Ld - k0) >> 5; kt_hi = kt_hi < nkt ? kt_hi : nkt;
        f32x16 o[2]; float scale, lse2;
        const bool has_sink = d.sink != nullptr; const float sinkv = has_sink ? d.sink[hh] * 1.4426950408889634f : 0.f;
        const bf16_t* qnrow = band_qrow(d, wt + 8 < ntiles ? wt + 8 : wt, ql, h);
        { f32x16 S[NKT]; attn_scores<NKT, 4, true>(Kl, rbase + qs + ql, bl, negl, kt_lo, kt_hi, qf, h, S);
#pragma unroll
          for (int d0 = 0; d0 < 4; ++d0) qf[d0] = *(const bf16x8*)(qnrow + 16 * d0);
          attn_finish<NKT, 4>(S, Vl, rbase + qs, 32768, sinkv, has_sink, lane, o, scale, lse2); }
        if (OUT8) store_o_tile8<2>(lds + ALDS_OST + wave * 2048, o, scale, (unsigned char*)d.op + (size_t)sub * d.o_sstride + (size_t)(d.q0 + qs) * d.o_tstride + hh * 64, d.o_tstride, lane);
        else store_o_tile<2>(lds + ALDS_OST + wave * 2048, o, scale, d.op + (size_t)sub * d.o_sstride + (size_t)(d.q0 + qs) * d.o_tstride + hh * 64, d.o_tstride, lane);
        if (d.lsep && h == 0) d.lsep[(size_t)sub * d.l_sstride + (size_t)qidx * d.l_tstride] = lse2;
    }
    __syncthreads();
}

__device__ __forceinline__ void mem_compute(LAS char* lds, const UDesc& d, const int wave, bf16x8 (&qf)[8]) {
    const int lane = lane_id(), ql = lane & 31, h = lane >> 5;
    LAS char* Kl = lds + ALDS_K; LAS char* Vl = lds + ALDS_V;
    for (int wt = wave; wt < 16; wt += 8) {
        const int tok = wt * 32 + ql;
        const bf16_t* qnrow = d.qp + (size_t)((wt + 8 < 16 ? wt + 8 : wt) * 32 + ql) * NQKV + 8 * h;
        f32x16 o[4]; float scale, lse2;
        { f32x16 S[8]; attn_scores<8, 8, false>(Kl, ql, nullptr, nullptr, 0, 8, qf, h, S);
#pragma unroll
          for (int d0 = 0; d0 < 8; ++d0) qf[d0] = *(const bf16x8*)(qnrow + 16 * d0);
          attn_finish<8, 8>(S, Vl, 0, 16384, 0.f, false, lane, o, scale, lse2); }
        store_o_tile8<4>(lds + ALDS_OST + wave * 2048, o, scale, (unsigned char*)d.op + (size_t)(wt * 32) * (LDH * 2), LDH * 2, lane);
    }
    __syncthreads();
}

__device__ __forceinline__ void transpose_item(const float* W, int ldsrc, int c0, int nblk, bf16_t* WT, int ldd, int dcol, const float* g, int scale_mode, LAS float* scr, int item, int lane) {
    const int kb = item / nblk, nbi = item - kb * nblk, k0 = 64 * kb, n0 = 32 * nbi;
    float cs = 1.f;
    if (scale_mode == 1) { const int n = n0; cs = (n < 512 || (n >= 768 && n < 1536)) ? 0.125f * 1.4426950408889634f : (n >= 3072 ? 0.08838834764831845f * 1.4426950408889634f : 1.f); }
#pragma unroll 8
    for (int i = 0; i < 32; ++i) { const int kk = 2 * i + (lane >> 5); float v = W[(size_t)(k0 + kk) * ldsrc + c0 + n0 + (lane & 31)]; if (g) v *= g[k0 + kk]; scr[kk * 33 + (lane & 31)] = v * cs; }
    asm volatile("s_waitcnt lgkmcnt(0)" ::: "memory");
    const int c = lane & 7;
#pragma unroll
    for (int j = 0; j < 4; ++j) { const int n = (lane >> 3) + 8 * j; const LAS float* s = scr + (8 * c) * 33 + n;
        u32x4 o; o.x = pk2(s[0 * 33], s[1 * 33]); o.y = pk2(s[2 * 33], s[3 * 33]); o.z = pk2(s[4 * 33], s[5 * 33]); o.w = pk2(s[6 * 33], s[7 * 33]);
        *(u32x4*)(WT + (size_t)(n0 + n) * ldd + dcol + k0 + 8 * c) = o; }
    asm volatile("s_waitcnt lgkmcnt(0)" ::: "memory");
}
template <int NRW>
__device__ __forceinline__ void rms_rows_to_bf16(const float* const (&xrow)[NRW], bf16_t* const (&orow)[NRW], unsigned char* const (&o8row)[NRW], int lane) {
    f32x4 v[NRW][4];
#pragma unroll
    for (int r = 0; r < NRW; ++r)
#pragma unroll
        for (int j = 0; j < 4; ++j) v[r][j] = ((const f32x4*)xrow[r])[lane + 64 * j];
#pragma unroll
    for (int r = 0; r < NRW; ++r) { float s = 0.f;
#pragma unroll
        for (int j = 0; j < 4; ++j) s += (v[r][j].x * v[r][j].x + v[r][j].y * v[r][j].y) + (v[r][j].z * v[r][j].z + v[r][j].w * v[r][j].w);
        const float rstd = rsqrtf(wave_sum(s) * (1.f / DM) + EPS);
        if (orow[r]) { u32x2* o8 = (u32x2*)orow[r] + lane;
#pragma unroll
            for (int j = 0; j < 4; ++j) { u32x2 w; w.x = pk2(v[r][j].x * rstd, v[r][j].y * rstd); w.y = pk2(v[r][j].z * rstd, v[r][j].w * rstd); o8[64 * j] = w; } }
        if (o8row[r]) { unsigned* q8 = (unsigned*)o8row[r] + lane;
#pragma unroll
            for (int j = 0; j < 4; ++j) q8[64 * j] = pk_fp8x4(v[r][j].x * rstd, v[r][j].y * rstd, v[r][j].z * rstd, v[r][j].w * rstd); } }
}
__device__ __forceinline__ void transpose_item8(const float* W, int ldsrc, int c0, int nblk, unsigned char* W8, const float* g, int scale_mode, float mult, LAS float* scr, int item, int lane, int ldd = 1024, int dcol = 0) {
    const int kb = item / nblk, nbi = item - kb * nblk, k0 = 64 * kb, n0 = 32 * nbi;
    float cs = mult;
    if (scale_mode == 1) { const int n = n0; cs *= (n < 512 || (n >= 768 && n < 1536)) ? 0.125f * 1.4426950408889634f : (n >= 3072 ? 0.08838834764831845f * 1.4426950408889634f : 1.f); }
#pragma unroll 8
    for (int i = 0; i < 32; ++i) { const int kk = 2 * i + (lane >> 5); float v = W[(size_t)(k0 + kk) * ldsrc + c0 + n0 + (lane & 31)]; if (g) v *= g[k0 + kk]; scr[kk * 33 + (lane & 31)] = v * cs; }
    asm volatile("s_waitcnt lgkmcnt(0)" ::: "memory");
    const int c = lane & 7;
#pragma unroll
    for (int j = 0; j < 4; ++j) { const int n = (lane >> 3) + 8 * j; const LAS float* sp = scr + (8 * c) * 33 + n;
        u32x2 o; o.x = pk_fp8x4(sp[0 * 33], sp[1 * 33], sp[2 * 33], sp[3 * 33]); o.y = pk_fp8x4(sp[4 * 33], sp[5 * 33], sp[6 * 33], sp[7 * 33]);
        *(u32x2*)(W8 + (size_t)(n0 + n) * ldd + dcol + k0 + 8 * c) = o; }
    asm volatile("s_waitcnt lgkmcnt(0)" ::: "memory");
}

#ifndef REPMASK
#define REPMASK 0
#endif
#ifndef REPMASK
#define REPMASK 0
#endif
#define XB_TMO      128
#define XB_XCNT(j)  (256  + 64 * (j))
#define XB_XSUB(j)  (1280 + 64 * (j))
#define XB_XGEN(j)  (2304 + 64 * (j))
#define XB_TOP      3328
#define XB_TOPGEN   3392
#define XB_SPIN_CAP (1u << 22)
__device__ __forceinline__ unsigned xb_ld(unsigned* p)              { return __hip_atomic_load(p, __ATOMIC_RELAXED, __HIP_MEMORY_SCOPE_AGENT); }
__device__ __forceinline__ unsigned xb_add(unsigned* p, unsigned v) { return __hip_atomic_fetch_add(p, v, __ATOMIC_RELAXED, __HIP_MEMORY_SCOPE_AGENT); }
__device__ __forceinline__ unsigned xb_xcc_id() { return (unsigned)__builtin_amdgcn_s_getreg((3 << 11) | 20) & 0xFu; }
#define XB_SPIN(cond, bar) do { unsigned _sp = 0; while (cond) { __builtin_amdgcn_s_sleep(1); \
    if ((++_sp & 255u) == 0u) { if (xb_ld(&(bar)[XB_TMO])) break; if (_sp > XB_SPIN_CAP) { atomicAdd(&(bar)[XB_TMO], 1u); break; } } } } while (0)
struct XcdBarrier { unsigned* bar; unsigned x; volatile LAS unsigned* st; };
__device__ __forceinline__ void xcd_barrier_complete(unsigned* bar, unsigned x, unsigned& nloc, unsigned& nx) {
    const unsigned G = gridDim.x;
    unsigned sum, cnt, mine, sp = 0u;
    for (;;) {
        sum = 0u; cnt = 0u; mine = 0u;
#pragma unroll
        for (unsigned j = 0; j < 16; ++j) { const unsigned c = xb_ld(&bar[XB_XCNT(j)]); sum += c; cnt += (c > 0u) ? 1u : 0u; mine = (j == x) ? c : mine; }
        if (sum == G) break;
        __builtin_amdgcn_s_sleep(1);
        if ((++sp & 255u) == 0u) { if (xb_ld(&bar[XB_TMO])) break; if (sp > XB_SPIN_CAP) { atomicAdd(&bar[XB_TMO], 1u); break; } }
    }
    nloc = mine > 0u ? mine : 1u; nx = cnt > 0u ? cnt : 1u;
}
__device__ __forceinline__ void xcd_barrier(const XcdBarrier& b, const int wave) {
    asm volatile("s_waitcnt vmcnt(0)" ::: "memory");
    __syncthreads();
    if (wave == 0 && lane_id() == 0) {
        unsigned* bar = b.bar;
        __builtin_amdgcn_s_waitcnt(0);
        unsigned nloc = b.st[0], nx = b.st[1];
        if (nloc == 0u) { xcd_barrier_complete(bar, b.x, nloc, nx); b.st[0] = nloc; b.st[1] = nx; }
        const unsigned old = xb_add(&bar[XB_XSUB(b.x)], 1u);
        const unsigned gen = old / nloc;
        if (old + 1u == (gen + 1u) * nloc) {
            __builtin_amdgcn_fence(__ATOMIC_RELEASE, "agent");
            asm volatile("s_waitcnt vmcnt(0)" ::: "memory");
            const unsigned og = xb_add(&bar[XB_TOP], 1u);
            const unsigned tg = og / nx;
            if (og + 1u == (tg + 1u) * nx) xb_add(&bar[XB_TOPGEN], 1u);
            else XB_SPIN(xb_ld(&bar[XB_TOPGEN]) == tg, bar);
            __builtin_amdgcn_fence(__ATOMIC_ACQUIRE, "agent");
            xb_add(&bar[XB_XGEN(b.x)], 1u);
            asm volatile("s_waitcnt vmcnt(0)" ::: "memory");
        } else {
            XB_SPIN(xb_ld(&bar[XB_XGEN(b.x)]) == gen, bar);
            __builtin_amdgcn_fence(__ATOMIC_ACQUIRE, "agent");
            asm volatile("s_waitcnt vmcnt(0)" ::: "memory");
        }
    }
    __syncthreads();
}

struct Args { const float* in[18]; float* out; unsigned char* ws; };

__global__ void __launch_bounds__(512, 2) fwd_megakernel(Args args) {
    extern __shared__ __attribute__((aligned(16))) unsigned char lds_raw[];
    LAS unsigned char* lds = (LAS unsigned char*)lds_raw;
    cg::grid_group grid = cg::this_grid();
    const int wave = __builtin_amdgcn_readfirstlane(threadIdx.x >> 6);
    const int G = gridDim.x, bx = blockIdx.x;
    XcdBarrier xbar; xbar.bar = (unsigned*)(args.ws + 32768); xbar.x = xb_xcc_id(); xbar.st = (volatile LAS unsigned*)(lds + 138240);
    if (threadIdx.x == 0) { xbar.st[0] = 0u; xbar.st[1] = 0u; (void)xb_add(&xbar.bar[XB_XCNT(xbar.x)], 1u); }
    unsigned char* ws = args.ws;
    const float* x_p = args.in[0]; const float* x_s = args.in[1]; const float* mem_p = args.in[2]; const float* mem_s = args.in[3];
    const float* rel_bias = args.in[4]; const float* norm1_g = args.in[5]; const float* w_in = args.in[6]; const float* mem_norm_g = args.in[7];
    const float* w_mem_kv = args.in[8]; const float* sink_logit = args.in[9]; const float* w_br_a = args.in[10]; const float* w_br_b = args.in[11];
    const float* w_br_m = args.in[12]; const float* w_out = args.in[13]; const float* norm2_g = args.in[14]; const float* w_up = args.in[15];
    const float* w_down = args.in[16]; const float* final_g = args.in[17];
    float* out = args.out;
    float* biasA = (float*)(ws + WS_BIASA); float* biasB = (float*)(ws + WS_BIASB);
    bf16_t* Wqkv = (bf16_t*)(ws + WS_WQKV); bf16_t* W3 = (bf16_t*)(ws + WS_W3); bf16_t* Wmem = (bf16_t*)(ws + WS_WMEM); bf16_t* Wout = (bf16_t*)(ws + WS_WOUT);
    bf16_t* Wup = (bf16_t*)(ws + WS_WUP); bf16_t* Wdn = (bf16_t*)(ws + WS_WDN);
    bf16_t* memn = (bf16_t*)(ws + WS_MEMN); bf16_t* mkv = (bf16_t*)(ws + WS_MKV); float* ssq = (float*)(ws + WS_SSQ); float* lse = (float*)(ws + WS_LSE);
    bf16_t* qkv = (bf16_t*)(ws + WS_QKV); bf16_t* hcat = (bf16_t*)(ws + WS_HCAT); bf16_t* x1b = (bf16_t*)(ws + WS_X1B); bf16_t* merged = (bf16_t*)(ws + WS_MERGED);
    bf16_t* hid = (bf16_t*)(ws + WS_HID);
    unsigned char* h8 = (unsigned char*)out + 160 * MiB; unsigned char* Wg8 = (unsigned char*)out + 248 * MiB; unsigned char* Wqkv8 = (unsigned char*)out + 252 * MiB;
    bf16_t* og = (bf16_t*)((unsigned char*)out + DO_OG);

    for (int rep_ = 0; rep_ < 1 + ((REPMASK >> 0) & 1); ++rep_) {
        const int lane = lane_id(), tid = wave * 64 + lane;
        LAS float* scr = (LAS float*)(lds + wave * 16384);
        const int gw = bx * 8 + wave, NGW = G * 8;
        constexpr int I1 = 16 * 112, I2 = 16 * 32, I3 = 8 * 32, I4 = 4 * 32, I6 = 16 * 32, I8 = 16 * 128, I9 = 64 * 32;
        constexpr int NITEMS = I1 + 3 * I2 + I3 + I4 + I3 + I6 + I6 + I8 + I9;
        for (int it = gw; it < NITEMS; it += NGW) {
            int r = it;
            if (r < I1) { transpose_item8(w_in, NIN, 0, 112, Wqkv8, norm1_g, 1, 128.0f, scr, r, lane); continue; } r -= I1;
            if (r < 3 * I2) { const int br = r / I2; transpose_item8(w_in, NIN, NQKV + 1024 * br, 32, (unsigned char*)W3, norm1_g, 0, 32.0f, scr, r - br * I2, lane, 4352, 1024 * br); continue; } r -= 3 * I2;
            if (r < I3) { transpose_item8(w_br_a, 1024, 0, 32, (unsigned char*)W3, nullptr, 0, 32.0f, scr, r, lane, 4352, 3072); continue; } r -= I3;
            if (r < I4) { transpose_item8(w_br_b, 1024, 0, 32, (unsigned char*)W3, nullptr, 0, 32.0f, scr, r, lane, 4352, 3072 + 512); continue; } r -= I4;
            if (r < I3) { transpose_item8(w_br_m, 1024, 0, 32, (unsigned char*)W3, nullptr, 0, 32.0f, scr, r, lane, 4352, 3072 + 768); continue; } r -= I3;
            if (r < I6) { transpose_item(w_mem_kv, 1024, 0, 32, Wmem, 1024, 0, mem_norm_g, 0, scr, r, lane); continue; } r -= I6;
            if (r < I6) { transpose_item8(w_out, 1024, 0, 32, (unsigned char*)Wout, nullptr, 0, 32.0f, scr, r, lane); continue; } r -= I6;
            if (r < I8) { transpose_item(w_up, DFF, 0, 128, Wup, 1024, 0, norm2_g, 0, scr, r, lane); continue; } r -= I8;
            transpose_item(w_down, 1024, 0, 32, Wdn, DFF, 0, nullptr, 0, scr, r, lane);
        }
        for (int row = gw; row < TT; row += 4 * NGW) {
            const float* xr[4]; bf16_t* orw[4]; unsigned char* o8[4];
#pragma unroll
            for (int r = 0; r < 4; ++r) { int rw = row + r * NGW; rw = rw < TT ? rw : row; xr[r] = rw < TP ? x_p + (size_t)rw * DM : x_s + (size_t)(rw - TP) * DM; orw[r] = nullptr; o8[r] = (unsigned char*)hcat + (size_t)rw * (LDH * 2); }
            rms_rows_to_bf16<4>(xr, orw, o8, lane);
        }
        for (int row = gw; row < TMEM; row += NGW) {
            const float* xr[1] = {row < 32 * NMEM ? mem_p + (size_t)row * DM : mem_s + (size_t)(row - 32 * NMEM) * DM}; bf16_t* orw[1] = {memn + (size_t)row * DM}; unsigned char* o8[1] = {nullptr};
            rms_rows_to_bf16<1>(xr, orw, o8, lane);
        }
        const int gt = bx * 512 + tid;
        if (gt < 8 * NBA) { const int hd = gt / NBA, o = gt - hd * NBA - 32; biasA[gt] = (o >= 0 && o <= 256) ? rel_bias[t5_bucket(o - 128) * 20 + hd] * 1.4426950408889634f : -1e30f; }
        else if (gt < 8 * NBA + 12 * NBB) { const int e = gt - 8 * NBA, hd = e / NBB, o = e - hd * NBB - 32, gi = hd >> 2; const int dil = gi == 0 ? 1 : (gi == 1 ? 4 : 16);
            biasB[e] = (o >= 0 && o <= 128) ? rel_bias[t5_bucket(dil * (o - 64)) * 20 + 8 + hd] * 1.4426950408889634f : -1e30f; }
    }
    if (args.out == nullptr) grid.sync();
    xcd_barrier(xbar, wave);

    for (int rep_ = 0; rep_ < 1 + ((REPMASK >> 1) & 1); ++rep_) {
        int nt8 = 8; asm volatile("" : "+s"(nt8));
        { pg8::Gemm g{hcat, (const bf16_t*)Wqkv8, LDH, 512}; pg8::SchedQkv S{bx, nt8}; pg8::EpiStoreBf16 E{qkv, NQKV, 1.0f / 128.0f};
          pg8::gemm_phase<pg8::EpiStoreBf16, pg8::SchedQkv, true, true, true>(lds, g, S, E, wave); }
        { pg8::Gemm g{memn, Wmem, 1024, 1024}; pg8::Sched<1> S{TMEM / 256, 4, G, bx >= 96 ? bx - 96 : (1 << 20), 16}; pg8::EpiStoreBf16 E{mkv, 1024, 1.0f};
          pg8::gemm_phase<pg8::EpiStoreBf16, pg8::Sched<1>, true, true>(lds, g, S, E, wave); }
    }
    xcd_barrier(xbar, wave);

    for (int rep_ = 0; rep_ < 1 + ((REPMASK >> 2) & 1); ++rep_) {
        constexpr int NU_M = NB * 4 * 4, NU_A = NB * 2 * 8, NU_B = 3 * NB * 4 * 8, NU = NU_M + NU_A + NU_B;
        auto decode = [&](int u) -> UDesc {
            UDesc d;
            if (u < NU_M) {
                const int b = u >> 4, hm = (u >> 2) & 3, qc = u & 3; const size_t tok0 = (size_t)b * SEQ + qc * 512;
                d.type = 0; d.kp = mkv + (size_t)b * NMEM * 1024 + hm * 128; d.vp = d.kp + 512; d.qp = qkv + tok0 * NQKV + 3072 + hm * 128; d.op = (bf16_t*)((unsigned char*)hcat + tok0 * (LDH * 2) + 2048 + 768 + hm * 128);
                d.tstride = NQKV; d.sstride = 0; d.nh = 1; d.Ld = 256; d.q0 = 0; d.QB = 512; d.HALF = 0; d.nsub = 1; d.bias = biasA; d.sink = nullptr;
                d.o_tstride = LDH; d.o_sstride = 0; d.lsep = nullptr; d.l_tstride = 0; d.l_sstride = 0;
            } else if (u < NU_M + NU_A) {
                const int e = u - NU_M, b = e >> 4, kvh = (e >> 3) & 1, qb = e & 7;
                const bf16_t* base = qkv + (size_t)b * SEQ * NQKV;
                d.type = 1; d.qp = base + kvh * 256; d.kp = base + 512 + kvh * 64; d.vp = base + 640 + kvh * 64; d.tstride = NQKV; d.sstride = 0;
                d.nh = 4; d.Ld = SEQ; d.q0 = qb * 256; d.QB = 256; d.HALF = 128; d.nsub = 1;
                d.bias = biasA + kvh * 4 * NBA; d.sink = sink_logit + kvh * 4;
                d.op = (bf16_t*)((unsigned char*)hcat + (size_t)b * SEQ * (LDH * 2) + 2048 + kvh * 256); d.o_tstride = LDH * 2; d.o_sstride = 0; d.lsep = nullptr; d.l_tstride = 0; d.l_sstride = 0;
            } else {
                const int e = u - NU_M - NU_A, gi = e / (NB * 32), e2 = e - gi * (NB * 32), b = e2 >> 5, j = (e2 >> 3) & 3, blk = e2 & 7;
                const int hB = 4 * gi + j;
                int r, q0, dil;
                if (gi == 0) { dil = 1; r = 0; q0 = blk * 256; d.QB = 256; d.nsub = 1; d.Ld = 2048; }
                else if (gi == 1) { dil = 4; r = blk >> 1; q0 = (blk & 1) * 256; d.QB = 256; d.nsub = 1; d.Ld = 512; }
                else { dil = 16; r = blk * 2; q0 = 0; d.QB = 128; d.nsub = 2; d.Ld = 128; }
                const size_t tok0 = (size_t)b * SEQ + r;
                const bf16_t* base = qkv + tok0 * NQKV;
                d.type = 1; d.qp = base + 768 + hB * 64; d.kp = base + 1536 + hB * 64; d.vp = base + 2304 + hB * 64; d.tstride = (long)dil * NQKV; d.sstride = NQKV;
                d.nh = 1; d.q0 = q0; d.HALF = 64;
                d.bias = biasB + hB * NBB; d.sink = nullptr;
                d.op = og + ((size_t)gi * TT + tok0) * 256 + j * 64; d.o_tstride = (long)dil * 256; d.o_sstride = 256;
                d.lsep = lse + ((size_t)gi * TT + tok0) * 4 + j; d.l_tstride = (long)dil * 4; d.l_sstride = 4;
            }
            return d;
        };
        int u = bx;
        for (; u < NU_M; u += G) {
            const UDesc cur = decode(u);
            u32x4 kr[8], vr[8]; float bv[3]; stage_issue(cur, wave, kr, vr, bv);
            bf16x8 qf[8]; { const int lane = lane_id(); const bf16_t* qrow = cur.qp + (size_t)(wave * 32 + (lane & 31)) * NQKV + 8 * (lane >> 5);
#pragma unroll
              for (int d0 = 0; d0 < 8; ++d0) qf[d0] = *(const bf16x8*)(qrow + 16 * d0); }
            stage_commit(cur, (LAS char*)lds, wave, kr, vr, bv); __syncthreads();
            mem_compute((LAS char*)lds, cur, wave, qf);
        }
        for (; u < NU_M + NU_A; u += G) {
            const UDesc cur = decode(u);
            u32x4 kr[8], vr[8]; float bv[3]; stage_issue(cur, wave, kr, vr, bv);
            bf16x8 qf[4]; { const int lane = lane_id(); const bf16_t* qrow = band_qrow(cur, wave, lane & 31, lane >> 5);
#pragma unroll
              for (int d0 = 0; d0 < 4; ++d0) qf[d0] = *(const bf16x8*)(qrow + 16 * d0); }
            stage_commit(cur, (LAS char*)lds, wave, kr, vr, bv); __syncthreads();
            band_compute<9, true>((LAS char*)lds, cur, wave, qf);
        }
        for (; u < NU; u += G) {
            const UDesc cur = decode(u);
            u32x4 kr[8], vr[8]; float bv[3]; stage_issue(cur, wave, kr, vr, bv);
            bf16x8 qf[4]; { const int lane = lane_id(); const bf16_t* qrow = band_qrow(cur, wave, lane & 31, lane >> 5);
#pragma unroll
              for (int d0 = 0; d0 < 4; ++d0) qf[d0] = *(const bf16x8*)(qrow + 16 * d0); }
            stage_commit(cur, (LAS char*)lds, wave, kr, vr, bv); __syncthreads();
            band_compute<5, false>((LAS char*)lds, cur, wave, qf);
        }
    }
    xcd_barrier(xbar, wave);

    for (int rep_ = 0; rep_ < 1 + ((REPMASK >> 3) & 1); ++rep_) {
        const int tid = wave * 64 + lane_id();
        const size_t nitems = (size_t)TT * 32;
        for (size_t it = (size_t)bx * 512 + tid; it < nitems; it += (size_t)G * 512) {
            const size_t tok = it >> 5; const int j = (int)(it >> 3) & 3, c = (int)it & 7;
            const float l0 = lse[tok * 4 + j], l1 = lse[((size_t)TT + tok) * 4 + j], l2 = lse[((size_t)2 * TT + tok) * 4 + j];
            const float mx = fmaxf(l0, fmaxf(l1, l2)); float w0 = __builtin_amdgcn_exp2f(l0 - mx), w1 = __builtin_amdgcn_exp2f(l1 - mx), w2 = __builtin_amdgcn_exp2f(l2 - mx); const float inv = 1.0f / (w0 + w1 + w2);
            w0 *= inv; w1 *= inv; w2 *= inv;
            const u32x4 a = *(const u32x4*)(og + tok * 256 + j * 64 + c * 8), bq = *(const u32x4*)(og + ((size_t)TT + tok) * 256 + j * 64 + c * 8), cq = *(const u32x4*)(og + ((size_t)2 * TT + tok) * 256 + j * 64 + c * 8);
            float f[8];
#pragma unroll
            for (int e = 0; e < 4; ++e) { f[2 * e] = w0 * bf2f((unsigned short)(a[e] & 0xffff)) + w1 * bf2f((unsigned short)(bq[e] & 0xffff)) + w2 * bf2f((unsigned short)(cq[e] & 0xffff));
                f[2 * e + 1] = w0 * bf2f((unsigned short)(a[e] >> 16)) + w1 * bf2f((unsigned short)(bq[e] >> 16)) + w2 * bf2f((unsigned short)(cq[e] >> 16)); }
            u32x2 o; o.x = pk_fp8x4(f[0] * 16.f, f[1] * 16.f, f[2] * 16.f, f[3] * 16.f); o.y = pk_fp8x4(f[4] * 16.f, f[5] * 16.f, f[6] * 16.f, f[7] * 16.f);
            *(u32x2*)((unsigned char*)hcat + tok * (LDH * 2) + 2048 + 512 + j * 64 + c * 8) = o;
        }
    }
    xcd_barrier(xbar, wave);

    for (int rep_ = 0; rep_ < 1 + ((REPMASK >> 4) & 1); ++rep_) {
        u32x2* tbase = (u32x2*)out + (size_t)bx * (2 * 32 * 512);
        pg8::Gemm g{hcat, W3, LDH, 2176}; pg8::Sched<6> S{TT / 256, 4, G, bx, 0}; pg8::EpiGate6 E{tbase, merged};
        pg8::gemm_phase<pg8::EpiGate6, pg8::Sched<6>, true, true, true>(lds, g, S, E, wave);
    }
    xcd_barrier(xbar, wave);

    for (int rep_ = 0; rep_ < 1 + ((REPMASK >> 5) & 1); ++rep_) {
        int nt8 = 8; asm volatile("" : "+s"(nt8));
        pg8::Gemm g{merged, Wout, 512, 512}; pg8::Sched<1> S{TT / 256, 4, G, bx, nt8}; pg8::EpiOut E{x_p, x_s, out, x1b, ssq, 1.0f / 512.0f};
        pg8::gemm_phase<pg8::EpiOut, pg8::Sched<1>, true, true, true>(lds, g, S, E, wave);
    }
    xcd_barrier(xbar, wave);

    for (int rep_ = 0; rep_ < 1 + ((REPMASK >> 6) & 1); ++rep_) {
        pg8::Gemm g{x1b, Wup, 1024, 1024}; pg8::Sched<1> S{TT / 256, 16, G, bx, 16}; pg8::EpiUp E{hid, ssq};
        pg8::gemm_phase<pg8::EpiUp, pg8::Sched<1>, false, true>(lds, g, S, E, wave);
    }
    xcd_barrier(xbar, wave);

    for (int rep_ = 0; rep_ < 1; ++rep_) {
        pg8::Gemm g{hid, Wdn, DFF, DFF}; pg8::Sched<1> S{TT / 256, 4, G, bx, 64}; pg8::EpiDownNorm E{out, x1b, ssq, (unsigned*)(ws + 4096), final_g};
        pg8::gemm_phase<pg8::EpiDownNorm, pg8::Sched<1>, true, true>(lds, g, S, E, wave);
    }
}

extern "C" void kernel_launch(void* const* d_in, const int* in_sizes, int n_in, void* d_out, int out_size, void* d_ws, size_t ws_size, hipStream_t stream) {
    static int grid = 0;
    if (grid == 0) {
        if (n_in != 18 || out_size != TT * DM || ws_size < WS_END) { fprintf(stderr, "kernel_launch: unexpected shapes (n_in %d out %d ws %zu)\n", n_in, out_size, ws_size); grid = -1; return; }
        int dev = 0, cus = 0, per_cu = 0;
        hipGetDevice(&dev);
        hipDeviceGetAttribute(&cus, hipDeviceAttributeMultiprocessorCount, dev);
        hipFuncSetAttribute((const void*)fwd_megakernel, hipFuncAttributeMaxDynamicSharedMemorySize, LDS_BYTES);
        hipOccupancyMaxActiveBlocksPerMultiprocessor(&per_cu, (const void*)fwd_megakernel, 512, LDS_BYTES);
        if (per_cu < 1) { fprintf(stderr, "kernel_launch: occupancy query says %d blocks per CU\n", per_cu); per_cu = 1; }
        grid = cus * per_cu;
        if (grid < 256) { fprintf(stderr, "kernel_launch: needs 256 co-resident workgroups, device offers %d\n", grid); grid = -1; return; }
        grid = 256;
    }
    if (grid < 0) return;
    hipMemsetAsync(d_ws, 0, 65536, stream);
    Args a{};
    for (int i = 0; i < 18; ++i) a.in[i] = (const float*)d_in[i];
    a.out = (float*)d_out; a.ws = (unsigned char*)d_ws;
    void* kargs[] = {&a};
    hipError_t e = hipLaunchCooperativeKernel((const void*)fwd_megakernel, dim3(grid), dim3(512), kargs, LDS_BYTES, stream);
    if (e != hipSuccess) fprintf(stderr, "cooperative launch failed: %s (grid %d)\n", hipGetErrorString(e), grid);
}
```
